# Optimizing an MI355X kernel written in HIP

```python
import jax, jax.numpy as jnp
from jax import lax
import numpy as np

D_MODEL = 1024
BATCH = 16
SEQ = 2048
DEPTH = 1

N_META = 16
POOL_WIDTH = 512
POOL_WINDOWS = (2, 4, 8, 16)
POOL_GROUP = POOL_WIDTH // len(POOL_WINDOWS)
HEAD_DIM = 64
N_HEADS = 8
N_KV_HEADS = 2
Q_PER_KV = N_HEADS // N_KV_HEADS
ATTN_WIDTH = N_HEADS * HEAD_DIM
KV_WIDTH = N_KV_HEADS * HEAD_DIM
WINDOW = 128
BLOCK = 128
ROT_DIM = HEAD_DIM // 4
ROPE_THETA = 500000.0
MIX_WIDTH = POOL_WIDTH + ATTN_WIDTH
IN_WIDTH = POOL_WIDTH + ATTN_WIDTH + 2 * KV_WIDTH
N_GROUPS = 4
EXPERTS_PER_GROUP = 4
N_EXPERTS = N_GROUPS * EXPERTS_PER_GROUP
TOP_K = 2
D_EXPERT = 256
EPS = 1e-6
NEG_INF = -1e30

kernel_name = "hymba_pool_swa_sink_hmoe"


def rms_norm(x, gain):
    xf = x.astype(jnp.float32)
    y = xf * lax.rsqrt(jnp.mean(xf * xf, axis=-1, keepdims=True) + EPS)
    return (y * gain.astype(jnp.float32)).astype(x.dtype)


def partial_rope(t, pos):
    half = ROT_DIM // 2
    inv_freq = 1.0 / (ROPE_THETA ** (jnp.arange(half, dtype=jnp.float32) / half))
    ang = pos.astype(jnp.float32)[:, None] * inv_freq[None, :]
    cos = jnp.cos(ang)[:, None, :]
    sin = jnp.sin(ang)[:, None, :]
    tf = t.astype(jnp.float32)
    x1 = tf[..., :half]
    x2 = tf[..., half:ROT_DIM]
    out = jnp.concatenate([x1 * cos - x2 * sin, x2 * cos + x1 * sin, tf[..., ROT_DIM:]], axis=-1)
    return out.astype(t.dtype)


def multiscale_pool(u, w_pool, pool_scale):
    L = u.shape[1]
    pos = jnp.arange(L)
    outs = []
    for g, w in enumerate(POOL_WINDOWS):
        ug = u[..., g * POOL_GROUP:(g + 1) * POOL_GROUP].astype(jnp.float32)
        c = jnp.cumsum(ug, axis=1)
        c_prev = jnp.pad(c, ((0, 0), (w, 0), (0, 0)))[:, :L]
        count = jnp.minimum(pos + 1, w).astype(jnp.float32)[None, :, None]
        mixed = ((c - c_prev) / count - ug).astype(u.dtype)
        outs.append(jnp.einsum('blc,cd->bld', mixed, w_pool[g]))
    return jnp.concatenate(outs, axis=-1) * pool_scale


def sliding_window_attention(q, k, v, sinks):
    B, L = q.shape[0], q.shape[1]
    nb = -(-L // BLOCK)
    Lp = nb * BLOCK
    pad = ((0, 0), (0, Lp - L), (0, 0), (0, 0))
    qb = jnp.pad(q, pad).reshape(B, nb, BLOCK, N_KV_HEADS, Q_PER_KV, HEAD_DIM)
    kb = jnp.pad(k, pad).reshape(B, nb, BLOCK, N_KV_HEADS, HEAD_DIM)
    vb = jnp.pad(v, pad).reshape(B, nb, BLOCK, N_KV_HEADS, HEAD_DIM)
    shift = ((0, 0), (1, 0), (0, 0), (0, 0), (0, 0))
    k_band = jnp.concatenate([jnp.pad(kb, shift)[:, :nb], kb], axis=2)
    v_band = jnp.concatenate([jnp.pad(vb, shift)[:, :nb], vb], axis=2)
    k_meta = k[:, :N_META]
    v_meta = v[:, :N_META]
    scale = HEAD_DIM ** -0.5
    s_band = jnp.einsum('bnqkgd,bnjkd->bnkgqj', qb, k_band).astype(jnp.float32) * scale
    s_meta = jnp.einsum('bnqkgd,bmkd->bnkgqm', qb, k_meta).astype(jnp.float32) * scale
    q_pos = jnp.arange(nb)[:, None] * BLOCK + jnp.arange(BLOCK)[None, :]
    k_pos = jnp.arange(nb)[:, None] * BLOCK - BLOCK + jnp.arange(2 * BLOCK)[None, :]
    diff = q_pos[:, :, None] - k_pos[:, None, :]
    band_ok = (diff >= 0) & (diff < WINDOW) & (k_pos[:, None, :] >= 0)
    meta_ok = (q_pos[:, :, None] - jnp.arange(N_META)[None, None, :]) >= WINDOW
    s_band = jnp.where(band_ok[None, :, None, None], s_band, NEG_INF)
    s_meta = jnp.where(meta_ok[None, :, None, None], s_meta, NEG_INF)
    sink = jnp.broadcast_to(
        sinks.astype(jnp.float32).reshape(N_KV_HEADS, Q_PER_KV)[None, None, :, :, None, None],
        s_band.shape[:-1] + (1,))
    p = jax.nn.softmax(jnp.concatenate([s_band, s_meta, sink], axis=-1), axis=-1)
    p_band = p[..., :2 * BLOCK].astype(v.dtype)
    p_meta = p[..., 2 * BLOCK:2 * BLOCK + N_META].astype(v.dtype)
    o = (jnp.einsum('bnkgqj,bnjkd->bnqkgd', p_band, v_band)
         + jnp.einsum('bnkgqm,bmkd->bnqkgd', p_meta, v_meta))
    return o.reshape(B, Lp, ATTN_WIDTH)[:, :L]


def hierarchical_moe(x, w_group_router, w_expert_router, w_gate, w_up, w_down):
    B, L, D = x.shape
    t = x.reshape(B * L, D)
    group_probs = jax.nn.softmax((t @ w_group_router).astype(jnp.float32), axis=-1)
    g_prob, g_idx = lax.top_k(group_probs, 1)
    expert_logits = (t @ w_expert_router).astype(jnp.float32).reshape(-1, N_GROUPS, EXPERTS_PER_GROUP)
    g_onehot = jax.nn.one_hot(g_idx[:, 0], N_GROUPS, dtype=jnp.float32)
    in_group = jnp.einsum('tge,tg->te', expert_logits, g_onehot)
    e_logit, e_idx = lax.top_k(in_group, TOP_K)
    e_w = jax.nn.softmax(e_logit, axis=-1) * g_prob
    expert_id = g_idx * EXPERTS_PER_GROUP + e_idx
    gates = jnp.sum(jax.nn.one_hot(expert_id, N_EXPERTS, dtype=jnp.float32) * e_w[..., None], axis=1)
    hid = jax.nn.silu(jnp.einsum('td,edf->tef', t, w_gate)) * jnp.einsum('td,edf->tef', t, w_up)
    hid = hid * gates.astype(hid.dtype)[..., None]
    y = jnp.einsum('tef,efd->td', hid, w_down)
    return y.reshape(B, L, D)


def setup_inputs(seed: int = 0) -> dict:
    key = jax.random.key(seed)
    ks = jax.random.split(key, 20)
    f32 = jnp.float32
    n = lambda k, shape, s: jax.random.normal(k, shape, f32) * s
    return {
        "x": n(ks[0], (BATCH, SEQ, D_MODEL), 1.0),
        "meta_tokens": n(ks[1], (N_META, D_MODEL), 1.0),
        "attn_norm_gain": 1.0 + n(ks[2], (DEPTH, D_MODEL), 0.02),
        "w_in": n(ks[3], (DEPTH, D_MODEL, IN_WIDTH), D_MODEL ** -0.5),
        "w_pool": n(ks[4], (DEPTH, len(POOL_WINDOWS), POOL_GROUP, POOL_GROUP), POOL_GROUP ** -0.5),
        "pool_scale": 1.0 + n(ks[5], (DEPTH, POOL_WIDTH), 0.02),
        "q_norm_gain": 1.0 + n(ks[6], (DEPTH, HEAD_DIM), 0.02),
        "k_norm_gain": 1.0 + n(ks[7], (DEPTH, HEAD_DIM), 0.02),
        "attn_sinks": n(ks[8], (DEPTH, N_HEADS), 0.5),
        "w_out": n(ks[9], (DEPTH, MIX_WIDTH, D_MODEL), MIX_WIDTH ** -0.5),
        "ffn_norm_gain": 1.0 + n(ks[10], (DEPTH, D_MODEL), 0.02),
        "w_group_router": n(ks[11], (DEPTH, D_MODEL, N_GROUPS), D_MODEL ** -0.5),
        "w_expert_router": n(ks[12], (DEPTH, D_MODEL, N_EXPERTS), D_MODEL ** -0.5),
        "w_gate": n(ks[13], (DEPTH, N_EXPERTS, D_MODEL, D_EXPERT), D_MODEL ** -0.5),
        "w_up": n(ks[14], (DEPTH, N_EXPERTS, D_MODEL, D_EXPERT), D_MODEL ** -0.5),
        "w_down": n(ks[15], (DEPTH, N_EXPERTS, D_EXPERT, D_MODEL), D_EXPERT ** -0.5),
    }


def reference(x, meta_tokens, attn_norm_gain, w_in, w_pool, pool_scale, q_norm_gain, k_norm_gain,
              attn_sinks, w_out, ffn_norm_gain, w_group_router, w_expert_router, w_gate, w_up, w_down):
    B, S, D = x.shape
    meta = jnp.broadcast_to(meta_tokens[None].astype(x.dtype), (B, N_META, D))
    h = jnp.concatenate([meta, x], axis=1)
    L = S + N_META
    pos = jnp.arange(L)
    splits = [POOL_WIDTH, POOL_WIDTH + ATTN_WIDTH, POOL_WIDTH + ATTN_WIDTH + KV_WIDTH]
    for layer in range(DEPTH):
        a = rms_norm(h, attn_norm_gain[layer])
        proj = a @ w_in[layer]
        u, q, k, v = jnp.split(proj, splits, axis=-1)
        y_pool = multiscale_pool(u, w_pool[layer], pool_scale[layer])
        q = partial_rope(rms_norm(q.reshape(B, L, N_HEADS, HEAD_DIM), q_norm_gain[layer]), pos)
        k = partial_rope(rms_norm(k.reshape(B, L, N_KV_HEADS, HEAD_DIM), k_norm_gain[layer]), pos)
        v = v.reshape(B, L, N_KV_HEADS, HEAD_DIM)
        y_attn = sliding_window_attention(q, k, v, attn_sinks[layer])
        h = h + jnp.concatenate([y_pool, y_attn], axis=-1) @ w_out[layer]
        m = rms_norm(h, ffn_norm_gain[layer])
        h = h + hierarchical_moe(m, w_group_router[layer], w_expert_router[layer],
                                 w_gate[layer], w_up[layer], w_down[layer])
    return h[:, N_META:]
```

```cpp
#include <hip/hip_runtime.h>
#include <cstdio>
#include <cstdint>

#ifndef MK_N_LAUNCHES
#define MK_N_LAUNCHES 1
#endif

#define LAS __attribute__((address_space(3)))
#define GAS __attribute__((address_space(1)))
typedef unsigned short bf16_t;
typedef short bf16x8 __attribute__((ext_vector_type(8)));
typedef float f32x4 __attribute__((ext_vector_type(4)));
typedef float f32x2 __attribute__((ext_vector_type(2)));
typedef unsigned u32x4 __attribute__((ext_vector_type(4)));
typedef unsigned u32x2 __attribute__((ext_vector_type(2)));

constexpr int DM = 1024, NB = 16, SEQ = 2048, NMETA = 16, LSEQ = SEQ + NMETA, LP = 2080;
constexpr int T = NB * SEQ;
constexpr int TM = T + 256;
constexpr int INW = 1280, NHEAD = 8, NKVH = 2, HD = 64, NEXP = 16, DEXP = 256, NPAIR = 24;
constexpr float EPS = 1e-6f;
constexpr int MAXU = 4;

constexpr size_t MiB = 1u << 20;
constexpr size_t WS_CTL = 0, CTL_ZERO_BYTES = 1 * MiB;
constexpr size_t WS_WIN = 2 * MiB;
constexpr size_t WS_WOUT = 5 * MiB;
constexpr size_t WS_WGU = 8 * MiB;
constexpr size_t WS_WD = 24 * MiB;
constexpr size_t WS_WR = 32 * MiB;
constexpr size_t WS_ROPE = 33 * MiB;
constexpr size_t WS_RSTD1 = 34 * MiB;
constexpr size_t WS_RSTD2 = 35 * MiB;
constexpr size_t WS_WLO = 36 * MiB, WS_WHI = 37 * MiB;
constexpr size_t WS_SS2 = 38 * MiB;
constexpr size_t WS_LIST = 40 * MiB;
constexpr size_t WS_K = 44 * MiB;
constexpr size_t WS_V = 53 * MiB;
constexpr size_t WS_XB = 64 * MiB;
constexpr size_t WS_U = 130 * MiB;
constexpr size_t WS_Q = 164 * MiB;
constexpr size_t WS_YMIX = 196 * MiB;
constexpr size_t WS_H1 = 260 * MiB;
constexpr size_t WS_HID = 324 * MiB;
constexpr size_t WS_END = 364 * MiB;
constexpr int CW_CNT = 64;
constexpr int CW_BAR = 4096;

constexpr int RING_BYTES = 131072;
constexpr int TAB_OFF = RING_BYTES;
constexpr int TAB_TOK = TAB_OFF;
constexpr int TAB_RSTD = TAB_TOK + MAXU * 1024;
constexpr int TAB_WLO = TAB_RSTD + MAXU * 1024;
constexpr int TAB_WHI = TAB_WLO + MAXU * 1024;
constexpr int TAB_HDR = TAB_WHI + MAXU * 1024;
constexpr int MISC_OFF = TAB_HDR + 1024;
constexpr int LDS_BYTES = MISC_OFF + 128;
static_assert(LDS_BYTES <= 163840, "LDS map");

#define LDS_WAIT() asm volatile("s_waitcnt lgkmcnt(0)" ::: "memory")
#define VM_WAIT() asm volatile("s_waitcnt vmcnt(0)" ::: "memory")
__device__ __forceinline__ unsigned f2bf(float f) { unsigned u = __builtin_bit_cast(unsigned, f); return (u + 0x7fffu + ((u >> 16) & 1u)) >> 16; }
__device__ __forceinline__ unsigned pk2(float lo, float hi) { return f2bf(lo) | (f2bf(hi) << 16); }
__device__ __forceinline__ float bflo(unsigned w) { return __builtin_bit_cast(float, w << 16); }
__device__ __forceinline__ float bfhi(unsigned w) { return __builtin_bit_cast(float, w & 0xffff0000u); }
__device__ __forceinline__ float bf1(bf16_t h) { return __builtin_bit_cast(float, (unsigned)h << 16); }
__device__ __forceinline__ float wave_sum(float v) {
#pragma unroll
    for (int o = 1; o < 64; o <<= 1) v += __shfl_xor(v, o);
    return v;
}
__device__ __forceinline__ float wave_max(float v) {
#pragma unroll
    for (int o = 1; o < 64; o <<= 1) v = fmaxf(v, __shfl_xor(v, o));
    return v;
}

namespace pg8 {
constexpr int BM = 256, BK = 64, HALF = 128, HTB = HALF * BK * 2, STAGE_BYTES = 8 * HTB;
__host__ __device__ __forceinline__ int lds_byte(int r, int c) { const int st = (r >> 4) * 2 + (c >> 5), rr = r & 15, cc = c & 31, ob = rr * 64 + cc * 2; return st * 1024 + (ob ^ (((ob >> 9) & 1) << 5)); }
__host__ __device__ __forceinline__ void stage_rc(int b, int& R, int& C) { const int st = b / 1024, sb = b % 1024, swz = sb ^ (((sb >> 9) & 1) << 5); R = (st >> 1) * 16 + swz / 64; C = (st & 1) * 32 + (swz % 64) / 2; }
__host__ __device__ __forceinline__ int perm32(int rho) { const int n = rho >> 4, i = rho & 15; return 8 * (i >> 2) + 4 * n + (i & 3); }

struct Unit { int pm, pn, ui, x0, x1, nv; };
__device__ __forceinline__ unsigned cvt_pk_bf16(float lo, float hi) { unsigned r; asm volatile("v_cvt_pk_bf16_f32 %0, %1, %2" : "=v"(r) : "v"(lo), "v"(hi)); return r; }

template <class Prob, class Epi, class Sched>
__device__ __forceinline__ void gemm_phase(LAS unsigned char* lds, const Prob& P, const Sched& S, const Epi& E) {
    const int tid = threadIdx.x, wid = __builtin_amdgcn_readfirstlane(tid >> 6), lane = tid & 63, wr = wid >> 2, wc = wid & 3, fr = lane & 15, fq = lane >> 4;
    const int nt = P.K / BK;
    int Rp[2], Cp[2]; unsigned voffB[2];
#pragma unroll
    for (int i = 0; i < 2; ++i) { stage_rc(tid * 16 + i * 8192, Rp[i], Cp[i]); const int Rb = Epi::PERM ? ((Rp[i] & ~31) + perm32(Rp[i] & 31)) : Rp[i];
        voffB[i] = (unsigned)(Rb * P.ldb + Cp[i]) * 2u; }
    const size_t kstep = (size_t)(BK * 2);
    const size_t hstepB = (size_t)HALF * P.ldb * 2;
    const unsigned ldsw = (unsigned)wid * 1024u;
    const int aoff = lds_byte(wr * 64 + fr, fq * 8), boff = lds_byte(wc * 32 + fr, fq * 8);
#define PG8_SA(b, h) (((b) * 2 + (h)) * HTB)
#define PG8_SB(b, h) ((4 + (b) * 2 + (h)) * HTB)
#define PG8_STAGE(bufoff, gbase, voff) do { _Pragma("unroll") for (int _i = 0; _i < 2; ++_i) \
        __builtin_amdgcn_global_load_lds((const unsigned*)((const char*)(gbase) + (voff)[_i]), (LAS unsigned*)(lds + (bufoff) + ldsw + _i * 8192), 16, 0, 0); } while (0)
#define PG8_LDA(dst, b, h) do { _Pragma("unroll") for (int m = 0; m < 4; ++m) _Pragma("unroll") for (int k = 0; k < 2; ++k) dst[m][k] = *(const LAS bf16x8*)(lds + PG8_SA(b, h) + aoff + m * 2048 + k * 1024); } while (0)
#define PG8_LDB(dst, b, h) do { _Pragma("unroll") for (int n = 0; n < 2; ++n) _Pragma("unroll") for (int k = 0; k < 2; ++k) dst[n][k] = *(const LAS bf16x8*)(lds + PG8_SB(b, h) + boff + n * 2048 + k * 1024); } while (0)
#define PG8_MMA(ai, bj, At, Bt) do { __builtin_amdgcn_s_setprio(1); _Pragma("unroll") for (int m = 0; m < 4; ++m) _Pragma("unroll") for (int n = 0; n < 2; ++n) _Pragma("unroll") for (int k = 0; k < 2; ++k) \
        acc[ai][bj][m][n] = __builtin_amdgcn_mfma_f32_16x16x32_bf16(Bt[n][k], At[m][k], acc[ai][bj][m][n], 0, 0, 0); __builtin_amdgcn_s_setprio(0); } while (0)
#define PG8_WAIT_V(n) asm volatile("s_waitcnt vmcnt(" #n ")" ::: "memory")
#define PG8_WAIT_L(n) asm volatile("s_waitcnt lgkmcnt(" #n ")" ::: "memory")
#define PG8_BAR __builtin_amdgcn_s_barrier()
#define PG8_SCHED __builtin_amdgcn_sched_barrier(0)
    Unit cur, nxt; int ui = 0;
    if (!S.next(0, cur)) return;
    f32x4 acc[2][2][4][2];
#pragma unroll
    for (int a = 0; a < 2; ++a)
#pragma unroll
        for (int b = 0; b < 2; ++b)
#pragma unroll
            for (int m = 0; m < 4; ++m)
#pragma unroll
                for (int n = 0; n < 2; ++n) acc[a][b][m][n] = (f32x4){0.f, 0.f, 0.f, 0.f};
    bf16x8 At[4][2], B0[2][2], B1[2][2];
    unsigned voC[2][2], voN[2][2];
    P.a_voff(cur, Rp, Cp, voC);
    const char* cA = P.a_base(cur);
    {
        const char* b0 = P.b_tile(cur, 0); const char* b1 = P.b_tile(cur, 1);
        PG8_STAGE(PG8_SB(0, 0), b0, voffB); PG8_STAGE(PG8_SB(0, 1), b0 + hstepB, voffB); PG8_STAGE(PG8_SA(0, 0), cA, voC[0]); PG8_STAGE(PG8_SA(0, 1), cA, voC[1]);
        if (wr == 1) PG8_BAR;
        PG8_WAIT_V(2); PG8_BAR;
        PG8_STAGE(PG8_SB(1, 0), b1, voffB); PG8_STAGE(PG8_SA(1, 0), cA + kstep, voC[0]); PG8_STAGE(PG8_SB(1, 1), b1 + hstepB, voffB);
        PG8_WAIT_V(6); PG8_BAR;
    }
    for (;;) {
        const bool has_next = S.next(ui + 1, nxt);
        if (!has_next) nxt = cur;
        if constexpr (Prob::GATHER) P.a_voff(nxt, Rp, Cp, voN);
        const char* nA = P.a_base(nxt);
#pragma clang loop unroll(disable)
        for (int t = 0; t < nt; t += 2) {
            const bool last = (t == nt - 2);
            const char* a1 = cA + (size_t)(t + 1) * kstep;
            const char* a2 = last ? nA : cA + (size_t)(t + 2) * kstep;
            const char* a3 = a2 + kstep;
            const char* b2 = last ? P.b_tile(nxt, 0) : P.b_tile(cur, t + 2);
            const char* b3 = last ? P.b_tile(nxt, 1) : P.b_tile(cur, t + 3);
            unsigned v2[2][2];
#pragma unroll
            for (int h = 0; h < 2; ++h)
#pragma unroll
                for (int i = 0; i < 2; ++i) { if constexpr (Prob::GATHER) v2[h][i] = last ? voN[h][i] : voC[h][i]; else v2[h][i] = voC[h][i]; }
            PG8_LDB(B0, 0, 0); PG8_LDB(B1, 0, 1); PG8_SCHED; PG8_LDA(At, 0, 0); PG8_STAGE(PG8_SA(1, 1), a1, voC[1]);
            PG8_WAIT_V(8); PG8_WAIT_L(0); PG8_BAR; PG8_MMA(0, 0, At, B0); PG8_MMA(0, 1, At, B1); PG8_BAR; PG8_SCHED;
            PG8_LDA(At, 0, 1); PG8_STAGE(PG8_SB(0, 0), b2, voffB); PG8_STAGE(PG8_SB(0, 1), b2 + hstepB, voffB); PG8_STAGE(PG8_SA(0, 0), a2, v2[0]);
            PG8_WAIT_V(8); PG8_WAIT_L(0); PG8_BAR; PG8_MMA(1, 0, At, B0); PG8_MMA(1, 1, At, B1); PG8_BAR; PG8_SCHED;
            PG8_LDB(B0, 1, 0); PG8_LDB(B1, 1, 1); PG8_SCHED; PG8_LDA(At, 1, 0); PG8_STAGE(PG8_SA(0, 1), a2, v2[1]);
            PG8_WAIT_V(8); PG8_WAIT_L(0); PG8_BAR; PG8_MMA(0, 0, At, B0); PG8_MMA(0, 1, At, B1); PG8_BAR; PG8_SCHED;
            PG8_LDA(At, 1, 1); PG8_STAGE(PG8_SB(1, 0), b3, voffB); PG8_STAGE(PG8_SB(1, 1), b3 + hstepB, voffB); PG8_STAGE(PG8_SA(1, 0), a3, v2[0]);
            PG8_WAIT_V(8); PG8_WAIT_L(0); PG8_BAR; PG8_MMA(1, 0, At, B0); PG8_MMA(1, 1, At, B1); PG8_BAR; PG8_SCHED;
        }
        if (wr == 0) PG8_BAR;
        E(acc, cur, wr, wc, fr, fq);
        if (!has_next) break;
#pragma unroll
        for (int a = 0; a < 2; ++a)
#pragma unroll
            for (int b = 0; b < 2; ++b)
#pragma unroll
                for (int m = 0; m < 4; ++m)
#pragma unroll
                    for (int n = 0; n < 2; ++n) acc[a][b][m][n] = (f32x4){0.f, 0.f, 0.f, 0.f};
        cur = nxt; cA = nA; ++ui;
#pragma unroll
        for (int h = 0; h < 2; ++h)
#pragma unroll
            for (int i = 0; i < 2; ++i) { if constexpr (Prob::GATHER) voC[h][i] = voN[h][i]; }
        if (wr == 1) PG8_BAR;
    }
    PG8_WAIT_V(0);
    PG8_BAR;
#undef PG8_SA
#undef PG8_SB
#undef PG8_STAGE
#undef PG8_LDA
#undef PG8_LDB
#undef PG8_MMA
#undef PG8_WAIT_V
#undef PG8_WAIT_L
#undef PG8_BAR
#undef PG8_SCHED
}
}
using pg8::Unit;

typedef GAS unsigned gu32;
#define XB_TMO      128
#define XB_XCNT(j)  (256  + 64 * (j))
#define XB_XSUB(j)  (1280 + 64 * (j))
#define XB_XGEN(j)  (2304 + 64 * (j))
#define XB_TOP      3328
#define XB_TOPGEN   3392
#define XCD_BAR_WORDS 3456
#define XB_SPIN_CAP (1u << 18)
__device__ __forceinline__ unsigned xb_ld(unsigned* p)              { return __hip_atomic_load(p, __ATOMIC_RELAXED, __HIP_MEMORY_SCOPE_AGENT); }
__device__ __forceinline__ unsigned xb_add(unsigned* p, unsigned v) { return __hip_atomic_fetch_add(p, v, __ATOMIC_RELAXED, __HIP_MEMORY_SCOPE_AGENT); }
__device__ __forceinline__ unsigned xb_xcc_id() { return (unsigned)__builtin_amdgcn_s_getreg((3 << 11) | 20) & 0xFu; }
#define XB_SPIN(cond, bar) do { unsigned _sp = 0; while (cond) { __builtin_amdgcn_s_sleep(1); \
    if ((++_sp & 255u) == 0u) { if (xb_ld(&(bar)[XB_TMO])) break; if (_sp > XB_SPIN_CAP) { atomicAdd(&(bar)[XB_TMO], 1u); break; } } } } while (0)
struct XcdBarrier { unsigned* bar; unsigned x; volatile LAS unsigned* st; };
__device__ __forceinline__ XcdBarrier xcd_barrier_post(unsigned* bar, volatile LAS unsigned* st) {
    XcdBarrier b; b.bar = bar; b.x = xb_xcc_id(); b.st = st;
    if (threadIdx.x == 0) (void)xb_add(&bar[XB_XCNT(b.x)], 1u);
    return b;
}
__device__ __forceinline__ void xcd_barrier_complete(unsigned* bar, unsigned x, unsigned& nloc, unsigned& nx) {
    const unsigned G = gridDim.x * gridDim.y * gridDim.z;
    unsigned sum, cnt, mine, sp = 0u;
    for (;;) {
        sum = 0u; cnt = 0u; mine = 0u;
#pragma unroll
        for (unsigned j = 0; j < 16; ++j) { const unsigned c = xb_ld(&bar[XB_XCNT(j)]); sum += c; cnt += (c > 0u) ? 1u : 0u; mine = (j == x) ? c : mine; }
        if (sum == G) break;
        __builtin_amdgcn_s_sleep(1);
        if ((++sp & 255u) == 0u) { if (xb_ld(&bar[XB_TMO])) break; if (sp > XB_SPIN_CAP) { atomicAdd(&bar[XB_TMO], 1u); break; } }
    }
    nloc = mine > 0u ? mine : 1u; nx = cnt > 0u ? cnt : 1u;
}
__device__ __forceinline__ void xcd_barrier(const XcdBarrier& b) {
    asm volatile("s_waitcnt vmcnt(0)" ::: "memory");
    __syncthreads();
    if (threadIdx.x == 0) {
        unsigned* bar = b.bar;
        __builtin_amdgcn_s_waitcnt(0);
        unsigned nloc = b.st[0], nx = b.st[1];
        if (nloc == 0u) { xcd_barrier_complete(bar, b.x, nloc, nx); b.st[0] = nloc; b.st[1] = nx; }
        const unsigned old = xb_add(&bar[XB_XSUB(b.x)], 1u);
        const unsigned gen = old / nloc;
        if (old + 1u == (gen + 1u) * nloc) {
            __builtin_amdgcn_fence(__ATOMIC_RELEASE, "agent");
            asm volatile("s_waitcnt vmcnt(0)" ::: "memory");
            const unsigned og = xb_add(&bar[XB_TOP], 1u);
            const unsigned tg = og / nx;
            if (og + 1u == (tg + 1u) * nx) xb_add(&bar[XB_TOPGEN], 1u);
            else XB_SPIN(xb_ld(&bar[XB_TOPGEN]) == tg, bar);
            __builtin_amdgcn_fence(__ATOMIC_ACQUIRE, "agent");
            xb_add(&bar[XB_XGEN(b.x)], 1u);
            asm volatile("s_waitcnt vmcnt(0)" ::: "memory");
        } else {
            XB_SPIN(xb_ld(&bar[XB_XGEN(b.x)]) == gen, bar);
            __builtin_amdgcn_fence(__ATOMIC_ACQUIRE, "agent");
            asm volatile("s_waitcnt vmcnt(0)" ::: "memory");
        }
    }
    __syncthreads();
}

struct Frame {
    LAS unsigned char* lds;
    volatile LAS unsigned* MISC;
    unsigned* ctl;
    int tid, lane, wave, vcu, G;
    const float *x, *meta, *g1, *win, *wpool, *pscale, *qg, *kg, *sinks, *wout, *g2, *wgr, *wer, *wgate, *wup, *wdown;
    float* out;
    bf16_t *Win_t, *Wout_t, *Wgu_t, *Wd_t, *Wr_t, *XB, *UB, *QB, *KB, *VB, *YMIX, *H1, *HID;
    float *rope, *rstd1, *rstd2, *wlo, *whi, *ss2;
    int* list;
};

__device__ __forceinline__ void transpose_item(const float* W, int ldw, int k0, int n0, const float* scale, bf16_t* dst, int ldd, LAS float* scr, int lane) {
#pragma unroll 8
    for (int i = 0; i < 32; ++i) { const int kk = 2 * i + (lane >> 5); float v = W[(size_t)(k0 + kk) * ldw + n0 + (lane & 31)]; if (scale) v *= scale[k0 + kk]; scr[kk * 33 + (lane & 31)] = v; }
    LDS_WAIT(); asm volatile("" ::: "memory");
    const int c = lane & 7;
#pragma unroll
    for (int j = 0; j < 4; ++j) { const int n = (lane >> 3) + 8 * j; const LAS float* s = scr + (8 * c) * 33 + n;
        u32x4 o; o.x = pk2(s[0 * 33], s[1 * 33]); o.y = pk2(s[2 * 33], s[3 * 33]); o.z = pk2(s[4 * 33], s[5 * 33]); o.w = pk2(s[6 * 33], s[7 * 33]);
        *(u32x4*)(dst + (size_t)n * ldd + 8 * c) = o; }
    LDS_WAIT(); asm volatile("" ::: "memory");
}
__device__ __forceinline__ void row_to_bf16(const float* xrow, bf16_t* orow, float* rstd_out, int lane) {
    const f32x4* xr = (const f32x4*)xrow + lane;
    f32x4 v[4]; float s = 0.f;
#pragma unroll
    for (int j = 0; j < 4; ++j) { v[j] = xr[64 * j]; s += (v[j].x * v[j].x + v[j].y * v[j].y) + (v[j].z * v[j].z + v[j].w * v[j].w); }
    s = wave_sum(s);
    u32x2* o8 = (u32x2*)orow + lane;
#pragma unroll
    for (int j = 0; j < 4; ++j) { u32x2 w; w.x = pk2(v[j].x, v[j].y); w.y = pk2(v[j].z, v[j].w); o8[64 * j] = w; }
    if (lane == 0) *rstd_out = 1.0f / sqrtf(s * (1.0f / DM) + EPS);
}

__device__ __forceinline__ void p0_prologue(Frame& F) {
    LAS float* scr = (LAS float*)(F.lds + F.wave * 16384);
    const int gw = F.vcu * 8 + F.wave, NGW = F.G * 8, lane = F.lane;
    constexpr int I_WIN = 16 * 40, I_GU = 32 * 128, I_D = 16 * 128, I_O = 8 * 32;
    constexpr int NITEMS = I_WIN + I_GU + I_D + I_O;
    for (int it = gw; it < NITEMS; it += NGW) {
        int r = it;
        if (r < I_WIN) { const int kb = r / 40, sg = r % 40; int drow;
            if (sg < 16) drow = sg * 32;
            else if (sg < 32) { const int qc = (sg - 16) * 32, head = qc >> 6, half = (qc >> 5) & 1; drow = 256 * (2 + (head >> 2)) + 128 * half + 32 * (head & 3); }
            else { const int kc = (sg - 32) * 32, hh = kc >> 6, half = (kc >> 5) & 1; drow = 1024 + 128 * half + 32 * hh; }
            transpose_item(F.win, INW, kb * 64, sg * 32, F.g1, F.Win_t + (size_t)drow * DM + kb * 64, DM, scr, lane); continue; }
        r -= I_WIN;
        if (r < I_GU) { const int mat = r / 128, rr = r % 128, kb = rr / 8, fg = rr % 8, e = mat >> 1, isup = mat & 1;
            const float* W = (isup ? F.wup : F.wgate) + (size_t)e * DM * DEXP;
            const int drow = 256 * (fg >> 2) + 128 * isup + 32 * (fg & 3);
            transpose_item(W, DEXP, kb * 64, fg * 32, F.g2, F.Wgu_t + ((size_t)e * 512 + drow) * DM + kb * 64, DM, scr, lane); continue; }
        r -= I_GU;
        if (r < I_D) { const int e = r / 128, rr = r % 128, kb = rr / 32, nb = rr % 32;
            transpose_item(F.wdown + (size_t)e * DEXP * DM, DM, kb * 64, nb * 32, nullptr, F.Wd_t + ((size_t)e * DM + nb * 32) * DEXP + kb * 64, DEXP, scr, lane); continue; }
        r -= I_D;
        { const int kb = r / 32, nb = r % 32;
            transpose_item(F.wout + (size_t)512 * DM, DM, kb * 64, nb * 32, nullptr, F.Wout_t + (size_t)(nb * 32) * DM + 512 + kb * 64, DM, scr, lane); }
    }
    for (int it = gw; it < 1024; it += NGW) {
        const int g = it >> 8, cc = (it >> 4) & 15, nb = it & 15, n = nb * 64 + lane;
        float a[8];
#pragma unroll
        for (int j = 0; j < 8; ++j) a[j] = 0.f;
        const float* wp = F.wpool + ((size_t)g * 128 + cc * 8) * 128;
        for (int d = 0; d < 128; ++d) {
            const float wo = F.wout[(size_t)(g * 128 + d) * DM + n] * F.pscale[g * 128 + d];
#pragma unroll
            for (int j = 0; j < 8; ++j) a[j] += wp[j * 128 + d] * wo;
        }
        u32x4 o; o.x = pk2(a[0], a[1]); o.y = pk2(a[2], a[3]); o.z = pk2(a[4], a[5]); o.w = pk2(a[6], a[7]);
        *(u32x4*)(F.Wout_t + (size_t)n * DM + g * 128 + cc * 8) = o;
    }
    for (int i = gw * 64 + lane; i < 32 * DM; i += NGW * 64) {
        const int j = i >> 10, k = i & 1023; float v = 0.f;
        if (j < 16) v = F.wer[k * 16 + j] * F.g2[k]; else if (j < 20) v = F.wgr[k * 4 + (j - 16)] * F.g2[k];
        F.Wr_t[i] = (bf16_t)f2bf(v);
    }
    for (int i = gw * 64 + lane; i < LSEQ * 8; i += NGW * 64) {
        const int pos = i >> 3, fi = i & 7;
        double f = 1.0;
        if (fi == 1) f = 0.19392274474868576; if (fi == 2) f = 0.03760603093086393; if (fi == 3) f = 0.007292664737217109; if (fi == 4) f = 0.001414213562373095;
        if (fi == 5) f = 0.0002742481756762073; if (fi == 6) f = 5.318295896944988e-05; if (fi == 7) f = 1.031338537721246e-05;
        const double rev = (double)pos * f * 0.15915494309189535;
        const double fr = rev - __builtin_floor(rev + 0.5);
        const double qd = __builtin_floor(fr * 4.0 + 0.5);
        const double tt = (fr - qd * 0.25) * 6.283185307179586;
        const double t2 = tt * tt;
        const double sn = tt * (1.0 + t2 * (-1.0 / 6 + t2 * (1.0 / 120 + t2 * (-1.0 / 5040 + t2 * (1.0 / 362880 + t2 * (-1.0 / 39916800 + t2 * (1.0 / 6227020800.0)))))));
        const double cs = 1.0 + t2 * (-0.5 + t2 * (1.0 / 24 + t2 * (-1.0 / 720 + t2 * (1.0 / 40320 + t2 * (-1.0 / 3628800 + t2 * (1.0 / 479001600.0))))));
        const int qi = ((int)qd) & 3;
        const double c4 = (qi == 0) ? cs : (qi == 1) ? -sn : (qi == 2) ? -cs : sn;
        const double s4 = (qi == 0) ? sn : (qi == 1) ? cs : (qi == 2) ? -sn : -cs;
        F.rope[2 * i] = (float)c4; F.rope[2 * i + 1] = (float)s4;
    }
    for (int m = gw; m < T + NMETA; m += NGW) {
        const float* src = (m < T) ? F.x + (size_t)m * DM : F.meta + (size_t)(m - T) * DM;
        row_to_bf16(src, F.XB + (size_t)m * DM, F.rstd1 + m, lane);
    }
    for (int i = gw * 64 + lane; i < (256 - NMETA) * DM / 8; i += NGW * 64) ((u32x4*)(F.XB + (size_t)(T + NMETA) * DM))[i] = (u32x4){0u, 0u, 0u, 0u};
    for (int i = gw * 64 + lane; i < 256 - NMETA; i += NGW * 64) F.rstd1[T + NMETA + i] = 0.f;
    for (int i = gw * 64 + lane; i < 32 * 16 * 8; i += NGW * 64) { const int bh = i >> 7, r = (i >> 3) & 15, c = i & 7;
        const size_t off = ((size_t)bh * LP + LSEQ + r) * HD + c * 8; *(u32x4*)(F.KB + off) = (u32x4){0u, 0u, 0u, 0u}; *(u32x4*)(F.VB + off) = (u32x4){0u, 0u, 0u, 0u}; }
}

struct SchedP1 { int G, c;
    __device__ __forceinline__ bool next(int i, Unit& u) const { const int L = i * G + c; if (L >= 643) return false;
        if (L < 640) { u.pm = L / 5; u.pn = L % 5; } else { u.pm = 128; u.pn = (L == 642) ? 4 : (L - 640); }
        u.ui = 0; u.x0 = 0; u.x1 = 0; u.nv = 256; return true; } };
struct SchedP3 { int G, c;
    __device__ __forceinline__ bool next(int i, Unit& u) const { const int L = i * G + c; if (L >= 512) return false; u.pm = L >> 2; u.pn = L & 3; u.ui = 0; u.x0 = 0; u.x1 = 0; u.nv = 256; return true; } };
struct SchedMoe { const LAS int* hdr;
    __device__ __forceinline__ bool next(int i, Unit& u) const {
        const int n = __builtin_amdgcn_readfirstlane(hdr[MAXU * 8]); if (i >= n) return false;
        u.pm = __builtin_amdgcn_readfirstlane(hdr[i * 8 + 0]); u.pn = __builtin_amdgcn_readfirstlane(hdr[i * 8 + 1]);
        u.x0 = __builtin_amdgcn_readfirstlane(hdr[i * 8 + 2]); u.x1 = __builtin_amdgcn_readfirstlane(hdr[i * 8 + 3]);
        u.nv = __builtin_amdgcn_readfirstlane(hdr[i * 8 + 4]); u.ui = i; return true; } };

struct ProbLinear { static constexpr bool GATHER = false; const bf16_t* A; const bf16_t* Bt; int K, lda, ldb;
    __device__ __forceinline__ const char* a_base(const Unit& u) const { return (const char*)A + (size_t)u.pm * 256 * lda * 2; }
    __device__ __forceinline__ void a_voff(const Unit&, const int (&Rp)[2], const int (&Cp)[2], unsigned (&vo)[2][2]) const {
#pragma unroll
        for (int h = 0; h < 2; ++h)
#pragma unroll
            for (int i = 0; i < 2; ++i) vo[h][i] = (unsigned)((h * 128 + Rp[i]) * lda + Cp[i]) * 2u; }
    __device__ __forceinline__ const char* b_tile(const Unit& u, int kt) const { return (const char*)Bt + (size_t)u.pn * 256 * ldb * 2 + (size_t)kt * 128; } };
struct ProbG1 { static constexpr bool GATHER = true; const bf16_t* A; const bf16_t* Wgu; const LAS int* tokT; int K, lda, ldb;
    __device__ __forceinline__ const char* a_base(const Unit&) const { return (const char*)A; }
    __device__ __forceinline__ void a_voff(const Unit& u, const int (&Rp)[2], const int (&Cp)[2], unsigned (&vo)[2][2]) const {
#pragma unroll
        for (int h = 0; h < 2; ++h)
#pragma unroll
            for (int i = 0; i < 2; ++i) { const int tok = tokT[u.ui * 256 + h * 128 + Rp[i]]; vo[h][i] = (unsigned)(tok * DM + Cp[i]) * 2u; } }
    __device__ __forceinline__ const char* b_tile(const Unit& u, int kt) const { const int e = (u.pn < 2) ? u.x0 : u.x1;
        return (const char*)Wgu + ((size_t)e * 512 + (u.pn & 1) * 256) * DM * 2 + (size_t)kt * 128; } };
struct ProbG2 { static constexpr bool GATHER = false; const bf16_t* A; const bf16_t* Wd; int K, lda, ldb;
    __device__ __forceinline__ const char* a_base(const Unit& u) const { return (const char*)A + (size_t)u.pm * 256 * 512 * 2; }
    __device__ __forceinline__ void a_voff(const Unit&, const int (&Rp)[2], const int (&Cp)[2], unsigned (&vo)[2][2]) const {
#pragma unroll
        for (int h = 0; h < 2; ++h)
#pragma unroll
            for (int i = 0; i < 2; ++i) vo[h][i] = (unsigned)((h * 128 + Rp[i]) * 512 + Cp[i]) * 2u; }
    __device__ __forceinline__ const char* b_tile(const Unit& u, int kt) const { const int e = (kt < 4) ? u.x0 : u.x1;
        return (const char*)Wd + ((size_t)e * DM + u.pn * 256) * DEXP * 2 + (size_t)(kt & 3) * 128; } };

struct EpiP1 { static constexpr bool PERM = true;
    const float* rstd1; const float* rope; const float* qg; const float* kg; bf16_t *UB, *QB, *KB, *VB;
    __device__ __forceinline__ void operator()(const f32x4 (&acc)[2][2][4][2], const Unit& u, int wr, int wc, int fr, int fq) const {
        asm volatile("" : "+v"(fr), "+v"(fq));
        const bool meta = (u.pm == 128);
#pragma unroll
        for (int ai = 0; ai < 2; ++ai)
#pragma unroll
            for (int m = 0; m < 4; ++m) {
                const int rl = ai * 128 + wr * 64 + m * 16 + fr, grow = u.pm * 256 + rl;
                const float rs = rstd1[grow];
                const bool valid = !meta || rl < NMETA;
                const int b = grow >> 11, pos = meta ? rl : (grow & 2047) + NMETA;
                f32x4 v[2][2];
#pragma unroll
                for (int bj = 0; bj < 2; ++bj)
#pragma unroll
                    for (int n = 0; n < 2; ++n) v[bj][n] = acc[ai][bj][m][n] * rs;
                if (u.pn < 2) {
#pragma unroll
                    for (int bj = 0; bj < 2; ++bj) { u32x4 w; w.x = pg8::cvt_pk_bf16(v[bj][0][0], v[bj][0][1]); w.y = pg8::cvt_pk_bf16(v[bj][0][2], v[bj][0][3]); w.z = pg8::cvt_pk_bf16(v[bj][1][0], v[bj][1][1]); w.w = pg8::cvt_pk_bf16(v[bj][1][2], v[bj][1][3]);
                        const int col = u.pn * 256 + bj * 128 + wc * 32 + fq * 8;
                        if (!meta) *(u32x4*)(UB + ((size_t)b * LSEQ + pos) * 512 + col) = w;
                        else if (valid) { for (int bb = 0; bb < NB; ++bb) *(u32x4*)(UB + ((size_t)bb * LSEQ + pos) * 512 + col) = w; } }
                } else {
                    const bool isv = (u.pn == 4) && (wc >= 2);
                    if (!isv) {
                        float ss = 0.f;
#pragma unroll
                        for (int bj = 0; bj < 2; ++bj)
#pragma unroll
                            for (int n = 0; n < 2; ++n) ss += (v[bj][n][0] * v[bj][n][0] + v[bj][n][1] * v[bj][n][1]) + (v[bj][n][2] * v[bj][n][2] + v[bj][n][3] * v[bj][n][3]);
                        ss += __shfl_xor(ss, 16); ss += __shfl_xor(ss, 32);
                        const float rn = 1.0f / sqrtf(ss * (1.0f / HD) + EPS);
                        const float* gp = (u.pn == 4) ? kg : qg;
#pragma unroll
                        for (int bj = 0; bj < 2; ++bj)
#pragma unroll
                            for (int n = 0; n < 2; ++n) { const f32x4 gv = *(const f32x4*)(gp + 32 * bj + 8 * fq + 4 * n); v[bj][n] = v[bj][n] * rn * gv; }
#pragma unroll
                        for (int n = 0; n < 2; ++n) {
                            const f32x4 cs0 = *(const f32x4*)(rope + ((size_t)pos * 8 + 4 * n) * 2), cs1 = *(const f32x4*)(rope + ((size_t)pos * 8 + 4 * n) * 2 + 4);
                            const float c[4] = {cs0[0], cs0[2], cs1[0], cs1[2]}, s[4] = {cs0[1], cs0[3], cs1[1], cs1[3]};
#pragma unroll
                            for (int jj = 0; jj < 4; ++jj) { const float mine = v[0][n][jj], oth = __shfl_xor(mine, 16);
                                const float r = (fq == 0) ? (mine * c[jj] - oth * s[jj]) : (mine * c[jj] + oth * s[jj]);
                                v[0][n][jj] = (fq < 2) ? r : mine; }
                        }
                        if (u.pn != 4) {
#pragma unroll
                            for (int bj = 0; bj < 2; ++bj)
#pragma unroll
                                for (int n = 0; n < 2; ++n) v[bj][n] = v[bj][n] * 0.125f;
                        }
                    }
#pragma unroll
                    for (int bj = 0; bj < 2; ++bj) { u32x4 w; w.x = pg8::cvt_pk_bf16(v[bj][0][0], v[bj][0][1]); w.y = pg8::cvt_pk_bf16(v[bj][0][2], v[bj][0][3]); w.z = pg8::cvt_pk_bf16(v[bj][1][0], v[bj][1][1]); w.w = pg8::cvt_pk_bf16(v[bj][1][2], v[bj][1][3]);
                        const int d0 = 32 * bj + 8 * fq;
                        if (u.pn != 4) { const int head = 4 * (u.pn - 2) + wc; *(u32x4*)(QB + (size_t)grow * 512 + head * HD + d0) = w; }
                        else { bf16_t* base = (wc < 2) ? KB : VB; const int hh = wc & 1;
                            if (!meta) *(u32x4*)(base + (((size_t)b * 2 + hh) * LP + pos) * HD + d0) = w;
                            else if (valid) { for (int bb = 0; bb < NB; ++bb) *(u32x4*)(base + (((size_t)bb * 2 + hh) * LP + pos) * HD + d0) = w; } } }
                }
            }
    }
};
struct EpiP3 { static constexpr bool PERM = true;
    const float* x; bf16_t* H1; float* ss2;
    __device__ __forceinline__ void operator()(const f32x4 (&acc)[2][2][4][2], const Unit& u, int wr, int wc, int fr, int fq) const {
        asm volatile("" : "+v"(fr), "+v"(fq));
#pragma unroll
        for (int ai = 0; ai < 2; ++ai)
#pragma unroll
            for (int m = 0; m < 4; ++m) {
                const int grow = u.pm * 256 + ai * 128 + wr * 64 + m * 16 + fr; float ss = 0.f;
#pragma unroll
                for (int bj = 0; bj < 2; ++bj) { const size_t off = (size_t)grow * DM + u.pn * 256 + bj * 128 + wc * 32 + fq * 8;
                    const f32x4 h0 = *(const f32x4*)(x + off) + acc[ai][bj][m][0], h1 = *(const f32x4*)(x + off + 4) + acc[ai][bj][m][1];
                    ss += (h0[0] * h0[0] + h0[1] * h0[1]) + (h0[2] * h0[2] + h0[3] * h0[3]) + (h1[0] * h1[0] + h1[1] * h1[1]) + (h1[2] * h1[2] + h1[3] * h1[3]);
                    u32x4 w; w.x = pg8::cvt_pk_bf16(h0[0], h0[1]); w.y = pg8::cvt_pk_bf16(h0[2], h0[3]); w.z = pg8::cvt_pk_bf16(h1[0], h1[1]); w.w = pg8::cvt_pk_bf16(h1[2], h1[3]);
                    *(u32x4*)(H1 + off) = w; }
                ss += __shfl_xor(ss, 16); ss += __shfl_xor(ss, 32);
                if (fq == 0) ss2[(size_t)(u.pn * 4 + wc) * T + grow] = ss;
            }
    }
};
struct EpiG1 { static constexpr bool PERM = true;
    bf16_t* HID; const LAS float* rstdT; const LAS float* wloT; const LAS float* whiT;
    __device__ __forceinline__ void operator()(const f32x4 (&acc)[2][2][4][2], const Unit& u, int wr, int wc, int fr, int fq) const {
        asm volatile("" : "+v"(fr), "+v"(fq));
        const LAS float* wT = (u.pn < 2) ? wloT : whiT;
#pragma unroll
        for (int ai = 0; ai < 2; ++ai)
#pragma unroll
            for (int m = 0; m < 4; ++m) {
                const int rl = ai * 128 + wr * 64 + m * 16 + fr; const float rs = rstdT[u.ui * 256 + rl], w = wT[u.ui * 256 + rl];
                float h[8];
#pragma unroll
                for (int n = 0; n < 2; ++n)
#pragma unroll
                    for (int jj = 0; jj < 4; ++jj) { const float g = acc[ai][0][m][n][jj] * rs, up = acc[ai][1][m][n][jj] * rs;
                        h[n * 4 + jj] = g / (1.0f + __expf(-g)) * up * w; }
                u32x4 o; o.x = pg8::cvt_pk_bf16(h[0], h[1]); o.y = pg8::cvt_pk_bf16(h[2], h[3]); o.z = pg8::cvt_pk_bf16(h[4], h[5]); o.w = pg8::cvt_pk_bf16(h[6], h[7]);
                *(u32x4*)(HID + ((size_t)u.pm * 256 + rl) * 512 + u.pn * 128 + wc * 32 + fq * 8) = o;
            }
    }
};
struct EpiG2 { static constexpr bool PERM = false;
    float* out; const bf16_t* H1; const LAS int* tokT;
    __device__ __forceinline__ void operator()(const f32x4 (&acc)[2][2][4][2], const Unit& u, int wr, int wc, int fr, int fq) const {
        asm volatile("" : "+v"(fr), "+v"(fq));
#pragma unroll
        for (int ai = 0; ai < 2; ++ai)
#pragma unroll
            for (int m = 0; m < 4; ++m) {
                const int rl = ai * 128 + wr * 64 + m * 16 + fr; const int tok = tokT[u.ui * 256 + rl];
                if (rl < u.nv) {
#pragma unroll
                    for (int bj = 0; bj < 2; ++bj)
#pragma unroll
                        for (int n = 0; n < 2; ++n) { const size_t off = (size_t)tok * DM + u.pn * 256 + bj * 128 + wc * 32 + n * 16 + fq * 4;
                            const u32x2 hb = *(const u32x2*)(H1 + off);
                            f32x4 o = acc[ai][bj][m][n]; o[0] += bflo(hb.x); o[1] += bfhi(hb.x); o[2] += bflo(hb.y); o[3] += bfhi(hb.y);
                            *(f32x4*)(out + off) = o; }
                }
            }
    }
};

__device__ __forceinline__ void p2_pool(Frame& F) {
    const int gw = F.vcu * 8 + F.wave, NGW = F.G * 8, lane = F.lane;
    const int g = lane >> 4, w = 2 << g; const float invw = 1.0f / (float)w;
    for (int m = gw; m < T; m += NGW) {
        const int b = m >> 11, pos = (m & 2047) + NMETA;
        const bf16_t* up = F.UB + ((size_t)b * LSEQ + pos) * 512 + lane * 8;
        float a[8];
#pragma unroll
        for (int j = 0; j < 8; ++j) a[j] = 0.f;
        u32x4 self = *(const u32x4*)up;
        for (int i = 0; i < w; ++i) { const u32x4 q = *(const u32x4*)(up - (size_t)i * 512);
            a[0] += bflo(q.x); a[1] += bfhi(q.x); a[2] += bflo(q.y); a[3] += bfhi(q.y); a[4] += bflo(q.z); a[5] += bfhi(q.z); a[6] += bflo(q.w); a[7] += bfhi(q.w); }
        u32x4 o;
        o.x = pk2(a[0] * invw - bflo(self.x), a[1] * invw - bfhi(self.x)); o.y = pk2(a[2] * invw - bflo(self.y), a[3] * invw - bfhi(self.y));
        o.z = pk2(a[4] * invw - bflo(self.z), a[5] * invw - bfhi(self.z)); o.w = pk2(a[6] * invw - bflo(self.w), a[7] * invw - bfhi(self.w));
        *(u32x4*)(F.YMIX + (size_t)m * DM + lane * 8) = o;
    }
}
__device__ __forceinline__ void p2_attn_valu(Frame& F) {
    const int gw = F.vcu * 8 + F.wave, NGW = F.G * 8, lane = F.lane;
    LAS float* pl = (LAS float*)(F.lds + 65536) + F.wave * 192;
    for (int task = gw; task < T * NHEAD; task += NGW) {
        const int m = task >> 3, head = task & 7, b = m >> 11, pos = (m & 2047) + NMETA, kvh = head >> 2;
        const bf16_t* qp = F.QB + (size_t)m * 512 + head * HD;
        u32x4 qv[8];
#pragma unroll
        for (int i = 0; i < 8; ++i) qv[i] = *(const u32x4*)(qp + 8 * i);
        const bf16_t* Kp = F.KB + ((size_t)b * 2 + kvh) * LP * HD; const bf16_t* Vp = F.VB + ((size_t)b * 2 + kvh) * LP * HD;
        const bool contig = pos <= 143; const int nk = contig ? pos + 1 : 144;
        const float sink = F.sinks[head];
        float sc[3]; float mx = sink;
#pragma unroll
        for (int g = 0; g < 3; ++g) {
            const int i = g * 64 + lane; const bool valid = i < nk; const int key = contig ? i : (i < 16 ? i : pos - 143 + i);
            float d = 0.f;
            if (valid) { const bf16_t* kr = Kp + (size_t)key * HD;
#pragma unroll
                for (int c = 0; c < 8; ++c) { const u32x4 kk = *(const u32x4*)(kr + 8 * c); const u32x4 qq = qv[c];
                    d += bflo(kk.x) * bflo(qq.x) + bfhi(kk.x) * bfhi(qq.x) + bflo(kk.y) * bflo(qq.y) + bfhi(kk.y) * bfhi(qq.y)
                       + bflo(kk.z) * bflo(qq.z) + bfhi(kk.z) * bfhi(qq.z) + bflo(kk.w) * bflo(qq.w) + bfhi(kk.w) * bfhi(qq.w); } }
            sc[g] = valid ? d : -1e30f; mx = fmaxf(mx, sc[g]);
        }
        mx = wave_max(mx);
        float sum = 0.f;
#pragma unroll
        for (int g = 0; g < 3; ++g) { const int i = g * 64 + lane; const float p = (i < nk) ? __expf(sc[g] - mx) : 0.f; sum += p; pl[i] = p; }
        sum = wave_sum(sum) + __expf(sink - mx);
        LDS_WAIT(); asm volatile("" ::: "memory");
        float o = 0.f;
        for (int i = 0; i < nk; ++i) { const int key = contig ? i : (i < 16 ? i : pos - 143 + i); o += pl[i] * bf1(Vp[(size_t)key * HD + lane]); }
        F.YMIX[(size_t)m * DM + 512 + head * HD + lane] = (bf16_t)f2bf(o / sum);
        LDS_WAIT(); asm volatile("" ::: "memory");
    }
}

__device__ __forceinline__ void p4_route(Frame& F) {
    const int lane = F.lane, wave = F.wave, tid = F.tid;
    LAS float* lg = (LAS float*)(F.lds) + wave * 512;
    LAS int* hist = (LAS int*)(F.lds + 32768);
    for (int chunk = F.vcu; chunk < T / 128; chunk += F.G) {
        if (tid < 48) hist[tid] = 0;
        __syncthreads();
        const int tok0 = chunk * 128 + wave * 16;
        f32x4 a0 = {0.f, 0.f, 0.f, 0.f}, a1 = {0.f, 0.f, 0.f, 0.f};
        const bf16_t* hp = F.H1 + (size_t)(tok0 + (lane & 15)) * DM + 8 * (lane >> 4);
        const bf16_t* wp = F.Wr_t + (size_t)(lane & 15) * DM + 8 * (lane >> 4);
#pragma unroll 8
        for (int kk = 0; kk < 32; ++kk) { const bf16x8 a = *(const bf16x8*)(hp + kk * 32), b0 = *(const bf16x8*)(wp + kk * 32), b1 = *(const bf16x8*)(wp + 16 * DM + kk * 32);
            a0 = __builtin_amdgcn_mfma_f32_16x16x32_bf16(a, b0, a0, 0, 0, 0); a1 = __builtin_amdgcn_mfma_f32_16x16x32_bf16(a, b1, a1, 0, 0, 0); }
#pragma unroll
        for (int r = 0; r < 4; ++r) { lg[(4 * (lane >> 4) + r) * 32 + (lane & 15)] = a0[r]; lg[(4 * (lane >> 4) + r) * 32 + 16 + (lane & 15)] = a1[r]; }
        LDS_WAIT(); asm volatile("" ::: "memory");
        int p = 0, rank = 0; float wlo = 0.f, whi = 0.f, rs = 0.f; const int tok = tok0 + lane;
        if (lane < 16) {
            float ss = 0.f;
#pragma unroll
            for (int q = 0; q < 16; ++q) ss += F.ss2[(size_t)q * T + tok];
            rs = 1.0f / sqrtf(ss * (1.0f / DM) + EPS);
            const LAS float* l = lg + lane * 32;
            const float g0 = l[16] * rs, g1 = l[17] * rs, g2 = l[18] * rs, g3 = l[19] * rs;
            int gi = 0; float gm = g0; if (g1 > gm) { gm = g1; gi = 1; } if (g2 > gm) { gm = g2; gi = 2; } if (g3 > gm) { gm = g3; gi = 3; }
            const float gprob = 1.0f / (expf(g0 - gm) + expf(g1 - gm) + expf(g2 - gm) + expf(g3 - gm));
            const float e0 = l[gi * 4 + 0] * rs, e1 = l[gi * 4 + 1] * rs, e2 = l[gi * 4 + 2] * rs, e3 = l[gi * 4 + 3] * rs;
            int i1 = 0; float v1 = e0; if (e1 > v1) { v1 = e1; i1 = 1; } if (e2 > v1) { v1 = e2; i1 = 2; } if (e3 > v1) { v1 = e3; i1 = 3; }
            int i2 = -1; float v2 = -3.0e38f;
            if (i1 != 0 && e0 > v2) { v2 = e0; i2 = 0; } if (i1 != 1 && e1 > v2) { v2 = e1; i2 = 1; } if (i1 != 2 && e2 > v2) { v2 = e2; i2 = 2; } if (i1 != 3 && e3 > v2) { v2 = e3; i2 = 3; }
            const float p1 = 1.0f / (1.0f + expf(v2 - v1)), p2 = 1.0f - p1;
            const float w1 = p1 * gprob, w2 = p2 * gprob;
            const int lo = i1 < i2 ? i1 : i2, hi = i1 < i2 ? i2 : i1;
            wlo = i1 < i2 ? w1 : w2; whi = i1 < i2 ? w2 : w1;
            const int pidx = (lo == 0) ? (hi - 1) : (lo == 1 ? hi + 1 : 5);
            p = gi * 6 + pidx;
            rank = __hip_atomic_fetch_add(&hist[p], 1, __ATOMIC_RELAXED, __HIP_MEMORY_SCOPE_WORKGROUP);
        }
        __syncthreads();
        if (tid < NPAIR) hist[24 + tid] = (int)atomicAdd(F.ctl + CW_CNT + tid, (unsigned)hist[tid]);
        __syncthreads();
        if (lane < 16) { const int slot = hist[24 + p] + rank; F.list[(size_t)p * T + slot] = tok; F.rstd2[tok] = rs; F.wlo[tok] = wlo; F.whi[tok] = whi; }
        __syncthreads();
    }
}
__device__ __forceinline__ void moe_tables(Frame& F) {
    LAS int* tokT = (LAS int*)(F.lds + TAB_TOK); LAS float* rstdT = (LAS float*)(F.lds + TAB_RSTD); LAS float* wloT = (LAS float*)(F.lds + TAB_WLO); LAS float* whiT = (LAS float*)(F.lds + TAB_WHI);
    LAS int* hdr = (LAS int*)(F.lds + TAB_HDR); LAS int* pre = hdr + 64;
    const int tid = F.tid;
    if (tid < NPAIR) pre[32 + tid] = (int)__hip_atomic_load(F.ctl + CW_CNT + tid, __ATOMIC_RELAXED, __HIP_MEMORY_SCOPE_AGENT);
    __syncthreads();
    if (tid == 0) { int s = 0; for (int p = 0; p < NPAIR; ++p) { pre[p] = s; s += (pre[32 + p] + 255) >> 8; } pre[NPAIR] = s; }
    __syncthreads();
    const int NT = pre[NPAIR];
    int nu = 0;
    for (int ui = 0; ui < MAXU; ++ui) {
        const int L = ui * F.G + F.vcu; if (L >= 4 * NT) break;
        const int rt = L >> 2, j = L & 3; int p = 0;
        for (int q = 0; q < NPAIR; ++q) if (pre[q] <= rt && rt < pre[q + 1]) p = q;
        const int t = rt - pre[p], cntp = pre[32 + p]; const int nv = (cntp - 256 * t) < 256 ? (cntp - 256 * t) : 256;
        const int g = p / 6, pi = p % 6; const int lo = (pi < 3) ? 0 : (pi < 5 ? 1 : 2); const int hi = (pi < 3) ? pi + 1 : (pi < 5 ? pi - 1 : 3);
        if (tid == 0) { hdr[ui * 8 + 0] = rt; hdr[ui * 8 + 1] = j; hdr[ui * 8 + 2] = g * 4 + lo; hdr[ui * 8 + 3] = g * 4 + hi; hdr[ui * 8 + 4] = nv; }
        if (tid < 256) { const int r = tid < nv ? tid : 0; const int tok = F.list[(size_t)p * T + 256 * t + r];
            tokT[ui * 256 + tid] = tok; rstdT[ui * 256 + tid] = F.rstd2[tok]; wloT[ui * 256 + tid] = tid < nv ? F.wlo[tok] : 0.f; whiT[ui * 256 + tid] = tid < nv ? F.whi[tok] : 0.f; }
        ++nu;
    }
    if (tid == 0) hdr[MAXU * 8] = nu;
    __syncthreads();
}

struct Args { const float* in[16]; float* out; unsigned char* ws; int ph_lo, ph_hi; };
constexpr int N_LAUNCHES = MK_N_LAUNCHES;
constexpr int PER_PHASE = 7;

__global__ void __launch_bounds__(512, 2) hymba_fwd(Args args) {
    extern __shared__ __attribute__((aligned(16))) unsigned char lds[];
    Frame F;
    F.lds = (LAS unsigned char*)lds;
    F.MISC = (volatile LAS unsigned*)(F.lds + MISC_OFF);
    F.tid = threadIdx.x; F.lane = F.tid & 63; F.wave = __builtin_amdgcn_readfirstlane(F.tid >> 6);
    F.G = gridDim.x; { const int bx = blockIdx.x; F.vcu = (F.G % 8 == 0) ? (bx % 8) * (F.G / 8) + bx / 8 : bx; }
    unsigned char* ws = args.ws;
    F.ctl = (unsigned*)(ws + WS_CTL);
    F.x = args.in[0]; F.meta = args.in[1]; F.g1 = args.in[2]; F.win = args.in[3]; F.wpool = args.in[4]; F.pscale = args.in[5]; F.qg = args.in[6]; F.kg = args.in[7];
    F.sinks = args.in[8]; F.wout = args.in[9]; F.g2 = args.in[10]; F.wgr = args.in[11]; F.wer = args.in[12]; F.wgate = args.in[13]; F.wup = args.in[14]; F.wdown = args.in[15];
    F.out = args.out;
    F.Win_t = (bf16_t*)(ws + WS_WIN); F.Wout_t = (bf16_t*)(ws + WS_WOUT); F.Wgu_t = (bf16_t*)(ws + WS_WGU); F.Wd_t = (bf16_t*)(ws + WS_WD); F.Wr_t = (bf16_t*)(ws + WS_WR);
    F.XB = (bf16_t*)(ws + WS_XB); F.UB = (bf16_t*)(ws + WS_U); F.QB = (bf16_t*)(ws + WS_Q); F.KB = (bf16_t*)(ws + WS_K); F.VB = (bf16_t*)(ws + WS_V);
    F.YMIX = (bf16_t*)(ws + WS_YMIX); F.H1 = (bf16_t*)(ws + WS_H1); F.HID = (bf16_t*)(ws + WS_HID);
    F.rope = (float*)(ws + WS_ROPE); F.rstd1 = (float*)(ws + WS_RSTD1); F.rstd2 = (float*)(ws + WS_RSTD2); F.wlo = (float*)(ws + WS_WLO); F.whi = (float*)(ws + WS_WHI); F.ss2 = (float*)(ws + WS_SS2);
    F.list = (int*)(ws + WS_LIST);
    for (int u = F.tid; u < (LDS_BYTES - TAB_HDR) / 4; u += 512) ((LAS unsigned*)(F.lds + TAB_HDR))[u] = 0u;
    __syncthreads();
    XcdBarrier bar; bar.bar = (unsigned*)(F.ctl + CW_BAR); bar.x = 0; bar.st = nullptr;
    if (N_LAUNCHES == 1) bar = xcd_barrier_post((unsigned*)(F.ctl + CW_BAR), F.MISC + 8);
    const int lo = args.ph_lo, hi = args.ph_hi;
#ifndef PHASE_MASK
#define PHASE_MASK 0x7f
#endif
#define IN(k) (((PHASE_MASK >> (k)) & 1) && lo <= (k) && (k) < hi)
#define BOTH(k) (IN(k) && IN((k) + 1))
#define GRID_BAR() do { if (N_LAUNCHES == 1) xcd_barrier(bar); } while (0)

    if (IN(0)) { p0_prologue(F); if (BOTH(0)) GRID_BAR(); }

    if (IN(1)) {
        ProbLinear P{F.XB, F.Win_t, DM, DM, DM}; SchedP1 S{F.G, F.vcu};
        EpiP1 E{F.rstd1, F.rope, F.qg, F.kg, F.UB, F.QB, F.KB, F.VB};
        pg8::gemm_phase(F.lds, P, S, E);
        if (BOTH(1)) GRID_BAR();
    }
    if (IN(2)) { p2_pool(F); p2_attn_valu(F); if (BOTH(2)) GRID_BAR(); }
    if (IN(3)) {
        ProbLinear P{F.YMIX, F.Wout_t, DM, DM, DM}; SchedP3 S{F.G, F.vcu};
        EpiP3 E{F.x, F.H1, F.ss2};
        pg8::gemm_phase(F.lds, P, S, E);
        if (BOTH(3)) GRID_BAR();
    }
    if (IN(4)) { p4_route(F); if (BOTH(4)) GRID_BAR(); }
    if (IN(5)) {
        moe_tables(F);
        ProbG1 P{F.H1, F.Wgu_t, (const LAS int*)(F.lds + TAB_TOK), DM, DM, DM}; SchedMoe S{(const LAS int*)(F.lds + TAB_HDR)};
        EpiG1 E{F.HID, (const LAS float*)(F.lds + TAB_RSTD), (const LAS float*)(F.lds + TAB_WLO), (const LAS float*)(F.lds + TAB_WHI)};
        pg8::gemm_phase(F.lds, P, S, E);
        if (BOTH(5)) GRID_BAR();
    }
    if (IN(6)) {
        if (!IN(5)) moe_tables(F);
        ProbG2 P{F.HID, F.Wd_t, 512, 512, DEXP}; SchedMoe S{(const LAS int*)(F.lds + TAB_HDR)};
        EpiG2 E{F.out, F.H1, (const LAS int*)(F.lds + TAB_TOK)};
        pg8::gemm_phase(F.lds, P, S, E);
    }
#undef IN
#undef BOTH
}

extern "C" void kernel_launch(void* const* d_in, const int* in_sizes, int n_in, void* d_out, int out_size, void* d_ws, size_t ws_size, hipStream_t stream) {
    static int grid = 0;
    if (grid == 0) {
        if (n_in != 16 || in_sizes[0] != T * DM || out_size != T * DM || ws_size < WS_END) { fprintf(stderr, "kernel_launch: unexpected shapes (n_in %d, in0 %d, out %d, ws %zu)\n", n_in, n_in > 0 ? in_sizes[0] : -1, out_size, ws_size); grid = -1; return; }
        int dev = 0, cus = 0, per_cu = 0;
        if (hipGetDevice(&dev) != hipSuccess || hipDeviceGetAttribute(&cus, hipDeviceAttributeMultiprocessorCount, dev) != hipSuccess) { grid = -1; return; }
        if (hipFuncSetAttribute((const void*)hymba_fwd, hipFuncAttributeMaxDynamicSharedMemorySize, LDS_BYTES) != hipSuccess) { fprintf(stderr, "kernel_launch: hipFuncSetAttribute failed\n"); grid = -1; return; }
        if (hipOccupancyMaxActiveBlocksPerMultiprocessor(&per_cu, (const void*)hymba_fwd, 512, LDS_BYTES) != hipSuccess || per_cu < 1)
            fprintf(stderr, "kernel_launch: occupancy query reports %d workgroups per CU\n", per_cu);
        (void)hipGetLastError();
        grid = cus;
    }
    if (grid < 0) return;
    if (hipMemsetAsync((char*)d_ws + WS_CTL, 0, CTL_ZERO_BYTES, stream) != hipSuccess) { fprintf(stderr, "kernel_launch: memset failed\n"); return; }
    Args a{};
    for (int i = 0; i < 16; ++i) a.in[i] = (const float*)d_in[i];
    a.out = (float*)d_out; a.ws = (unsigned char*)d_ws;
    for (int li = 0; li < N_LAUNCHES; ++li) {
        a.ph_lo = (N_LAUNCHES == PER_PHASE) ? li : 0; a.ph_hi = (N_LAUNCHES == PER_PHASE) ? li + 1 : PER_PHASE;
        hipLaunchKernelGGL(hymba_fwd, dim3(grid), dim3(512), LDS_BYTES, stream, a);
        const hipError_t le = hipPeekAtLastError();
        if (le != hipSuccess) { fprintf(stderr, "kernel_launch: launch %d failed: %s\n", li, hipGetErrorName(le)); break; }
    }
}
```

```cpp
#include <hip/hip_runtime.h>
#include <cstdio>
#include <cstdint>

#ifndef MK_N_LAUNCHES
#define MK_N_LAUNCHES 1
#endif

#define LAS __attribute__((address_space(3)))
#define GAS __attribute__((address_space(1)))
typedef unsigned short bf16_t;
typedef short bf16x8 __attribute__((ext_vector_type(8)));
typedef float f32x4 __attribute__((ext_vector_type(4)));
typedef float f32x2 __attribute__((ext_vector_type(2)));
typedef unsigned u32x4 __attribute__((ext_vector_type(4)));
typedef unsigned u32x2 __attribute__((ext_vector_type(2)));

constexpr int DM = 1024, NB = 16, SEQ = 2048, NMETA = 16, LSEQ = SEQ + NMETA, LP = 2080;
constexpr int T = NB * SEQ;
constexpr int TM = T + 256;
constexpr int INW = 1280, NHEAD = 8, NKVH = 2, HD = 64, NEXP = 16, DEXP = 256, NPAIR = 24;
constexpr float EPS = 1e-6f;
constexpr float LOG2E = 1.4426950408889634f, QSCALE = 0.125f * LOG2E;
constexpr int MAXU = 4;

constexpr size_t MiB = 1u << 20;
constexpr size_t WS_CTL = 0, CTL_ZERO_BYTES = 1 * MiB;
constexpr size_t WS_WIN = 2 * MiB;
constexpr size_t WS_WOUT = 5 * MiB;
constexpr size_t WS_WGU = 8 * MiB;
constexpr size_t WS_WD = 24 * MiB;
constexpr size_t WS_WR = 32 * MiB;
constexpr size_t WS_ROPE = 33 * MiB;
constexpr size_t WS_RSTD1 = 34 * MiB;
constexpr size_t WS_RSTD2 = 35 * MiB;
constexpr size_t WS_WLO = 36 * MiB, WS_WHI = 37 * MiB;
constexpr size_t WS_SS2 = 38 * MiB;
constexpr size_t WS_LIST = 40 * MiB;
constexpr size_t WS_K = 44 * MiB;
constexpr size_t WS_V = 53 * MiB;
constexpr size_t WS_XB = 64 * MiB;
constexpr size_t WS_U = 130 * MiB;
constexpr size_t WS_Q = 164 * MiB;
constexpr size_t WS_YMIX = 196 * MiB;
constexpr size_t WS_H1 = 260 * MiB;
constexpr size_t WS_HID = 324 * MiB;
constexpr size_t WS_END = 364 * MiB;
constexpr int CW_CNT = 64;
constexpr int CW_BAR = 4096;

constexpr int RING_BYTES = 131072;
constexpr int TAB_OFF = RING_BYTES;
constexpr int TAB_TOK = TAB_OFF;
constexpr int TAB_RSTD = TAB_TOK + MAXU * 1024;
constexpr int TAB_WLO = TAB_RSTD + MAXU * 1024;
constexpr int TAB_WHI = TAB_WLO + MAXU * 1024;
constexpr int TAB_HDR = TAB_WHI + MAXU * 1024;
constexpr int MISC_OFF = TAB_HDR + 1024;
constexpr int LDS_BYTES = MISC_OFF + 128;
static_assert(LDS_BYTES <= 163840, "LDS map");

#define LDS_WAIT() asm volatile("s_waitcnt lgkmcnt(0)" ::: "memory")
#define VM_WAIT() asm volatile("s_waitcnt vmcnt(0)" ::: "memory")
__device__ __forceinline__ unsigned f2bf(float f) { unsigned u = __builtin_bit_cast(unsigned, f); return (u + 0x7fffu + ((u >> 16) & 1u)) >> 16; }
__device__ __forceinline__ unsigned pk2(float lo, float hi) { return f2bf(lo) | (f2bf(hi) << 16); }
__device__ __forceinline__ float bflo(unsigned w) { return __builtin_bit_cast(float, w << 16); }
__device__ __forceinline__ float bfhi(unsigned w) { return __builtin_bit_cast(float, w & 0xffff0000u); }
__device__ __forceinline__ float bf1(bf16_t h) { return __builtin_bit_cast(float, (unsigned)h << 16); }
__device__ __forceinline__ float wave_sum(float v) {
#pragma unroll
    for (int o = 1; o < 64; o <<= 1) v += __shfl_xor(v, o);
    return v;
}
__device__ __forceinline__ float wave_max(float v) {
#pragma unroll
    for (int o = 1; o < 64; o <<= 1) v = fmaxf(v, __shfl_xor(v, o));
    return v;
}

namespace pg8 {
constexpr int BM = 256, BK = 64, HALF = 128, HTB = HALF * BK * 2, STAGE_BYTES = 8 * HTB;
__host__ __device__ __forceinline__ int lds_byte(int r, int c) { const int st = (r >> 4) * 2 + (c >> 5), rr = r & 15, cc = c & 31, ob = rr * 64 + cc * 2; return st * 1024 + (ob ^ (((ob >> 9) & 1) << 5)); }
__host__ __device__ __forceinline__ void stage_rc(int b, int& R, int& C) { const int st = b / 1024, sb = b % 1024, swz = sb ^ (((sb >> 9) & 1) << 5); R = (st >> 1) * 16 + swz / 64; C = (st & 1) * 32 + (swz % 64) / 2; }
__host__ __device__ __forceinline__ int perm32(int rho) { const int n = rho >> 4, i = rho & 15; return 8 * (i >> 2) + 4 * n + (i & 3); }

struct Unit { int pm, pn, ui, x0, x1, nv; };
__device__ __forceinline__ unsigned cvt_pk_bf16(float lo, float hi) { unsigned r; asm volatile("v_cvt_pk_bf16_f32 %0, %1, %2" : "=v"(r) : "v"(lo), "v"(hi)); return r; }

template <class Prob, class Epi, class Sched>
__device__ __forceinline__ void gemm_phase(LAS unsigned char* lds, const Prob& P, const Sched& S, const Epi& E) {
    const int tid = threadIdx.x, wid = __builtin_amdgcn_readfirstlane(tid >> 6), lane = tid & 63, wr = wid >> 2, wc = wid & 3, fr = lane & 15, fq = lane >> 4;
    const int nt = P.K / BK;
    int Rp[2], Cp[2]; unsigned voffB[2];
#pragma unroll
    for (int i = 0; i < 2; ++i) { stage_rc(tid * 16 + i * 8192, Rp[i], Cp[i]); const int Rb = Epi::PERM ? ((Rp[i] & ~31) + perm32(Rp[i] & 31)) : Rp[i];
        voffB[i] = (unsigned)(Rb * P.ldb + Cp[i]) * 2u; }
    const size_t kstep = (size_t)(BK * 2);
    const size_t hstepB = (size_t)HALF * P.ldb * 2;
    const unsigned ldsw = (unsigned)wid * 1024u;
    const int aoff = lds_byte(wr * 64 + fr, fq * 8), boff = lds_byte(wc * 32 + fr, fq * 8);
#define PG8_SA(b, h) (((b) * 2 + (h)) * HTB)
#define PG8_SB(b, h) ((4 + (b) * 2 + (h)) * HTB)
#define PG8_STAGE(bufoff, gbase, voff) do { _Pragma("unroll") for (int _i = 0; _i < 2; ++_i) \
        __builtin_amdgcn_global_load_lds((const unsigned*)((const char*)(gbase) + (voff)[_i]), (LAS unsigned*)(lds + (bufoff) + ldsw + _i * 8192), 16, 0, 0); } while (0)
#define PG8_LDA(dst, b, h) do { _Pragma("unroll") for (int m = 0; m < 4; ++m) _Pragma("unroll") for (int k = 0; k < 2; ++k) dst[m][k] = *(const LAS bf16x8*)(lds + PG8_SA(b, h) + aoff + m * 2048 + k * 1024); } while (0)
#define PG8_LDB(dst, b, h) do { _Pragma("unroll") for (int n = 0; n < 2; ++n) _Pragma("unroll") for (int k = 0; k < 2; ++k) dst[n][k] = *(const LAS bf16x8*)(lds + PG8_SB(b, h) + boff + n * 2048 + k * 1024); } while (0)
#define PG8_MMA(ai, bj, At, Bt) do { __builtin_amdgcn_s_setprio(1); _Pragma("unroll") for (int m = 0; m < 4; ++m) _Pragma("unroll") for (int n = 0; n < 2; ++n) _Pragma("unroll") for (int k = 0; k < 2; ++k) \
        acc[ai][bj][m][n] = __builtin_amdgcn_mfma_f32_16x16x32_bf16(Bt[n][k], At[m][k], acc[ai][bj][m][n], 0, 0, 0); __builtin_amdgcn_s_setprio(0); } while (0)
#define PG8_WAIT_V(n) asm volatile("s_waitcnt vmcnt(" #n ")" ::: "memory")
#define PG8_WAIT_L(n) asm volatile("s_waitcnt lgkmcnt(" #n ")" ::: "memory")
#define PG8_BAR __builtin_amdgcn_s_barrier()
#define PG8_SCHED __builtin_amdgcn_sched_barrier(0)
    Unit cur, nxt; int ui = 0;
    if (!S.next(0, cur)) return;
    f32x4 acc[2][2][4][2];
#pragma unroll
    for (int a = 0; a < 2; ++a)
#pragma unroll
        for (int b = 0; b < 2; ++b)
#pragma unroll
            for (int m = 0; m < 4; ++m)
#pragma unroll
                for (int n = 0; n < 2; ++n) acc[a][b][m][n] = (f32x4){0.f, 0.f, 0.f, 0.f};
    bf16x8 At[4][2], B0[2][2], B1[2][2];
    unsigned voC[2][2], voN[2][2];
    P.a_voff(cur, Rp, Cp, voC);
    const char* cA = P.a_base(cur);
    {
        const char* b0 = P.b_tile(cur, 0); const char* b1 = P.b_tile(cur, 1);
        PG8_STAGE(PG8_SB(0, 0), b0, voffB); PG8_STAGE(PG8_SB(0, 1), b0 + hstepB, voffB); PG8_STAGE(PG8_SA(0, 0), cA, voC[0]); PG8_STAGE(PG8_SA(0, 1), cA, voC[1]);
        if (wr == 1) PG8_BAR;
        PG8_WAIT_V(2); PG8_BAR;
        PG8_STAGE(PG8_SB(1, 0), b1, voffB); PG8_STAGE(PG8_SA(1, 0), cA + kstep, voC[0]); PG8_STAGE(PG8_SB(1, 1), b1 + hstepB, voffB);
        PG8_WAIT_V(6); PG8_BAR;
    }
    for (;;) {
        const bool has_next = S.next(ui + 1, nxt);
        if (!has_next) nxt = cur;
        if constexpr (Prob::GATHER) P.a_voff(nxt, Rp, Cp, voN);
        const char* nA = P.a_base(nxt);
#pragma clang loop unroll(disable)
        for (int t = 0; t < nt; t += 2) {
            const bool last = (t == nt - 2);
            const char* a1 = cA + (size_t)(t + 1) * kstep;
            const char* a2 = last ? nA : cA + (size_t)(t + 2) * kstep;
            const char* a3 = a2 + kstep;
            const char* b2 = last ? P.b_tile(nxt, 0) : P.b_tile(cur, t + 2);
            const char* b3 = last ? P.b_tile(nxt, 1) : P.b_tile(cur, t + 3);
            unsigned v2[2][2];
#pragma unroll
            for (int h = 0; h < 2; ++h)
#pragma unroll
                for (int i = 0; i < 2; ++i) { if constexpr (Prob::GATHER) v2[h][i] = last ? voN[h][i] : voC[h][i]; else v2[h][i] = voC[h][i]; }
            PG8_LDB(B0, 0, 0); PG8_LDB(B1, 0, 1); PG8_SCHED; PG8_LDA(At, 0, 0); PG8_STAGE(PG8_SA(1, 1), a1, voC[1]);
            PG8_WAIT_V(8); PG8_WAIT_L(0); PG8_BAR; PG8_MMA(0, 0, At, B0); PG8_MMA(0, 1, At, B1); PG8_BAR; PG8_SCHED;
            PG8_LDA(At, 0, 1); PG8_STAGE(PG8_SB(0, 0), b2, voffB); PG8_STAGE(PG8_SB(0, 1), b2 + hstepB, voffB); PG8_STAGE(PG8_SA(0, 0), a2, v2[0]);
            PG8_WAIT_V(8); PG8_WAIT_L(0); PG8_BAR; PG8_MMA(1, 0, At, B0); PG8_MMA(1, 1, At, B1); PG8_BAR; PG8_SCHED;
            PG8_LDB(B0, 1, 0); PG8_LDB(B1, 1, 1); PG8_SCHED; PG8_LDA(At, 1, 0); PG8_STAGE(PG8_SA(0, 1), a2, v2[1]);
            PG8_WAIT_V(8); PG8_WAIT_L(0); PG8_BAR; PG8_MMA(0, 0, At, B0); PG8_MMA(0, 1, At, B1); PG8_BAR; PG8_SCHED;
            PG8_LDA(At, 1, 1); PG8_STAGE(PG8_SB(1, 0), b3, voffB); PG8_STAGE(PG8_SB(1, 1), b3 + hstepB, voffB); PG8_STAGE(PG8_SA(1, 0), a3, v2[0]);
            PG8_WAIT_V(8); PG8_WAIT_L(0); PG8_BAR; PG8_MMA(1, 0, At, B0); PG8_MMA(1, 1, At, B1); PG8_BAR; PG8_SCHED;
        }
        if (wr == 0) PG8_BAR;
        E(acc, cur, wr, wc, fr, fq);
        if (!has_next) break;
#pragma unroll
        for (int a = 0; a < 2; ++a)
#pragma unroll
            for (int b = 0; b < 2; ++b)
#pragma unroll
                for (int m = 0; m < 4; ++m)
#pragma unroll
                    for (int n = 0; n < 2; ++n) acc[a][b][m][n] = (f32x4){0.f, 0.f, 0.f, 0.f};
        cur = nxt; cA = nA; ++ui;
#pragma unroll
        for (int h = 0; h < 2; ++h)
#pragma unroll
            for (int i = 0; i < 2; ++i) { if constexpr (Prob::GATHER) voC[h][i] = voN[h][i]; }
        if (wr == 1) PG8_BAR;
    }
    PG8_WAIT_V(0);
    PG8_BAR;
#undef PG8_SA
#undef PG8_SB
#undef PG8_STAGE
#undef PG8_LDA
#undef PG8_LDB
#undef PG8_MMA
#undef PG8_WAIT_V
#undef PG8_WAIT_L
#undef PG8_BAR
#undef PG8_SCHED
}
}
using pg8::Unit;

typedef GAS unsigned gu32;
#define XB_TMO      128
#define XB_XCNT(j)  (256  + 64 * (j))
#define XB_XSUB(j)  (1280 + 64 * (j))
#define XB_XGEN(j)  (2304 + 64 * (j))
#define XB_TOP      3328
#define XB_TOPGEN   3392
#define XCD_BAR_WORDS 3456
#define XB_SPIN_CAP (1u << 18)
__device__ __forceinline__ unsigned xb_ld(unsigned* p)              { return __hip_atomic_load(p, __ATOMIC_RELAXED, __HIP_MEMORY_SCOPE_AGENT); }
__device__ __forceinline__ unsigned xb_add(unsigned* p, unsigned v) { return __hip_atomic_fetch_add(p, v, __ATOMIC_RELAXED, __HIP_MEMORY_SCOPE_AGENT); }
__device__ __forceinline__ unsigned xb_xcc_id() { return (unsigned)__builtin_amdgcn_s_getreg((3 << 11) | 20) & 0xFu; }
#define XB_SPIN(cond, bar) do { unsigned _sp = 0; while (cond) { __builtin_amdgcn_s_sleep(1); \
    if ((++_sp & 255u) == 0u) { if (xb_ld(&(bar)[XB_TMO])) break; if (_sp > XB_SPIN_CAP) { atomicAdd(&(bar)[XB_TMO], 1u); break; } } } } while (0)
struct XcdBarrier { unsigned* bar; unsigned x; volatile LAS unsigned* st; };
__device__ __forceinline__ XcdBarrier xcd_barrier_post(unsigned* bar, volatile LAS unsigned* st) {
    XcdBarrier b; b.bar = bar; b.x = xb_xcc_id(); b.st = st;
    if (threadIdx.x == 0) (void)xb_add(&bar[XB_XCNT(b.x)], 1u);
    return b;
}
__device__ __forceinline__ void xcd_barrier_complete(unsigned* bar, unsigned x, unsigned& nloc, unsigned& nx) {
    const unsigned G = gridDim.x * gridDim.y * gridDim.z;
    unsigned sum, cnt, mine, sp = 0u;
    for (;;) {
        sum = 0u; cnt = 0u; mine = 0u;
#pragma unroll
        for (unsigned j = 0; j < 16; ++j) { const unsigned c = xb_ld(&bar[XB_XCNT(j)]); sum += c; cnt += (c > 0u) ? 1u : 0u; mine = (j == x) ? c : mine; }
        if (sum == G) break;
        __builtin_amdgcn_s_sleep(1);
        if ((++sp & 255u) == 0u) { if (xb_ld(&bar[XB_TMO])) break; if (sp > XB_SPIN_CAP) { atomicAdd(&bar[XB_TMO], 1u); break; } }
    }
    nloc = mine > 0u ? mine : 1u; nx = cnt > 0u ? cnt : 1u;
}
__device__ __forceinline__ void xcd_barrier(const XcdBarrier& b) {
    asm volatile("s_waitcnt vmcnt(0)" ::: "memory");
    __syncthreads();
    if (threadIdx.x == 0) {
        unsigned* bar = b.bar;
        __builtin_amdgcn_s_waitcnt(0);
        unsigned nloc = b.st[0], nx = b.st[1];
        if (nloc == 0u) { xcd_barrier_complete(bar, b.x, nloc, nx); b.st[0] = nloc; b.st[1] = nx; }
        const unsigned old = xb_add(&bar[XB_XSUB(b.x)], 1u);
        const unsigned gen = old / nloc;
        if (old + 1u == (gen + 1u) * nloc) {
            __builtin_amdgcn_fence(__ATOMIC_RELEASE, "agent");
            asm volatile("s_waitcnt vmcnt(0)" ::: "memory");
            const unsigned og = xb_add(&bar[XB_TOP], 1u);
            const unsigned tg = og / nx;
            if (og + 1u == (tg + 1u) * nx) xb_add(&bar[XB_TOPGEN], 1u);
            else XB_SPIN(xb_ld(&bar[XB_TOPGEN]) == tg, bar);
            __builtin_amdgcn_fence(__ATOMIC_ACQUIRE, "agent");
            xb_add(&bar[XB_XGEN(b.x)], 1u);
            asm volatile("s_waitcnt vmcnt(0)" ::: "memory");
        } else {
            XB_SPIN(xb_ld(&bar[XB_XGEN(b.x)]) == gen, bar);
            __builtin_amdgcn_fence(__ATOMIC_ACQUIRE, "agent");
            asm volatile("s_waitcnt vmcnt(0)" ::: "memory");
        }
    }
    __syncthreads();
}

struct Frame {
    LAS unsigned char* lds;
    volatile LAS unsigned* MISC;
    unsigned* ctl;
    int tid, lane, wave, vcu, G;
    const float *x, *meta, *g1, *win, *wpool, *pscale, *qg, *kg, *sinks, *wout, *g2, *wgr, *wer, *wgate, *wup, *wdown;
    float* out;
    bf16_t *Win_t, *Wout_t, *Wgu_t, *Wd_t, *Wr_t, *XB, *UB, *QB, *KB, *VB, *YMIX, *H1, *HID;
    float *rope, *rstd1, *rstd2, *wlo, *whi, *ss2;
    int* list;
};

__device__ __forceinline__ void transpose_item(const float* W, int ldw, int k0, int n0, const float* scale, bf16_t* dst, int ldd, LAS float* scr, int lane) {
#pragma unroll 8
    for (int i = 0; i < 32; ++i) { const int kk = 2 * i + (lane >> 5); float v = W[(size_t)(k0 + kk) * ldw + n0 + (lane & 31)]; if (scale) v *= scale[k0 + kk]; scr[kk * 33 + (lane & 31)] = v; }
    LDS_WAIT(); asm volatile("" ::: "memory");
    const int c = lane & 7;
#pragma unroll
    for (int j = 0; j < 4; ++j) { const int n = (lane >> 3) + 8 * j; const LAS float* s = scr + (8 * c) * 33 + n;
        u32x4 o; o.x = pk2(s[0 * 33], s[1 * 33]); o.y = pk2(s[2 * 33], s[3 * 33]); o.z = pk2(s[4 * 33], s[5 * 33]); o.w = pk2(s[6 * 33], s[7 * 33]);
        *(u32x4*)(dst + (size_t)n * ldd + 8 * c) = o; }
    LDS_WAIT(); asm volatile("" ::: "memory");
}
__device__ __forceinline__ void row_to_bf16(const float* xrow, bf16_t* orow, float* rstd_out, int lane) {
    const f32x4* xr = (const f32x4*)xrow + lane;
    f32x4 v[4]; float s = 0.f;
#pragma unroll
    for (int j = 0; j < 4; ++j) { v[j] = xr[64 * j]; s += (v[j].x * v[j].x + v[j].y * v[j].y) + (v[j].z * v[j].z + v[j].w * v[j].w); }
    s = wave_sum(s);
    u32x2* o8 = (u32x2*)orow + lane;
#pragma unroll
    for (int j = 0; j < 4; ++j) { u32x2 w; w.x = pk2(v[j].x, v[j].y); w.y = pk2(v[j].z, v[j].w); o8[64 * j] = w; }
    if (lane == 0) *rstd_out = 1.0f / sqrtf(s * (1.0f / DM) + EPS);
}

__device__ __forceinline__ void p0_prologue(Frame& F) {
    LAS float* scr = (LAS float*)(F.lds + F.wave * 16384);
    const int gw = F.vcu * 8 + F.wave, NGW = F.G * 8, lane = F.lane;
    constexpr int I_WIN = 16 * 40, I_GU = 32 * 128, I_D = 16 * 128, I_O = 8 * 32;
    constexpr int NITEMS = I_WIN + I_GU + I_D + I_O;
    for (int it = gw; it < NITEMS; it += NGW) {
        int r = it;
        if (r < I_WIN) { const int kb = r / 40, sg = r % 40; int drow;
            if (sg < 16) drow = sg * 32;
            else if (sg < 32) { const int qc = (sg - 16) * 32, head = qc >> 6, half = (qc >> 5) & 1; drow = 256 * (2 + (head >> 2)) + 128 * half + 32 * (head & 3); }
            else { const int kc = (sg - 32) * 32, hh = kc >> 6, half = (kc >> 5) & 1; drow = 1024 + 128 * half + 32 * hh; }
            transpose_item(F.win, INW, kb * 64, sg * 32, F.g1, F.Win_t + (size_t)drow * DM + kb * 64, DM, scr, lane); continue; }
        r -= I_WIN;
        if (r < I_GU) { const int mat = r / 128, rr = r % 128, kb = rr / 8, fg = rr % 8, e = mat >> 1, isup = mat & 1;
            const float* W = (isup ? F.wup : F.wgate) + (size_t)e * DM * DEXP;
            const int drow = 256 * (fg >> 2) + 128 * isup + 32 * (fg & 3);
            transpose_item(W, DEXP, kb * 64, fg * 32, F.g2, F.Wgu_t + ((size_t)e * 512 + drow) * DM + kb * 64, DM, scr, lane); continue; }
        r -= I_GU;
        if (r < I_D) { const int e = r / 128, rr = r % 128, kb = rr / 32, nb = rr % 32;
            transpose_item(F.wdown + (size_t)e * DEXP * DM, DM, kb * 64, nb * 32, nullptr, F.Wd_t + ((size_t)e * DM + nb * 32) * DEXP + kb * 64, DEXP, scr, lane); continue; }
        r -= I_D;
        { const int kb = r / 32, nb = r % 32;
            transpose_item(F.wout + (size_t)512 * DM, DM, kb * 64, nb * 32, nullptr, F.Wout_t + (size_t)(nb * 32) * DM + 512 + kb * 64, DM, scr, lane); }
    }
    for (int it = gw; it < 1024; it += NGW) {
        const int g = it >> 8, cc = (it >> 4) & 15, nb = it & 15, n = nb * 64 + lane;
        float a[8];
#pragma unroll
        for (int j = 0; j < 8; ++j) a[j] = 0.f;
        const float* wp = F.wpool + ((size_t)g * 128 + cc * 8) * 128;
        for (int d = 0; d < 128; ++d) {
            const float wo = F.wout[(size_t)(g * 128 + d) * DM + n] * F.pscale[g * 128 + d];
#pragma unroll
            for (int j = 0; j < 8; ++j) a[j] += wp[j * 128 + d] * wo;
        }
        u32x4 o; o.x = pk2(a[0], a[1]); o.y = pk2(a[2], a[3]); o.z = pk2(a[4], a[5]); o.w = pk2(a[6], a[7]);
        *(u32x4*)(F.Wout_t + (size_t)n * DM + g * 128 + cc * 8) = o;
    }
    for (int i = gw * 64 + lane; i < 32 * DM; i += NGW * 64) {
        const int j = i >> 10, k = i & 1023; float v = 0.f;
        if (j < 16) v = F.wer[k * 16 + j] * F.g2[k]; else if (j < 20) v = F.wgr[k * 4 + (j - 16)] * F.g2[k];
        F.Wr_t[i] = (bf16_t)f2bf(v);
    }
    for (int i = gw * 64 + lane; i < LSEQ * 8; i += NGW * 64) {
        const int pos = i >> 3, fi = i & 7;
        double f = 1.0;
        if (fi == 1) f = 0.19392274474868576; if (fi == 2) f = 0.03760603093086393; if (fi == 3) f = 0.007292664737217109; if (fi == 4) f = 0.001414213562373095;
        if (fi == 5) f = 0.0002742481756762073; if (fi == 6) f = 5.318295896944988e-05; if (fi == 7) f = 1.031338537721246e-05;
        const double rev = (double)pos * f * 0.15915494309189535;
        const double fr = rev - __builtin_floor(rev + 0.5);
        const double qd = __builtin_floor(fr * 4.0 + 0.5);
        const double tt = (fr - qd * 0.25) * 6.283185307179586;
        const double t2 = tt * tt;
        const double sn = tt * (1.0 + t2 * (-1.0 / 6 + t2 * (1.0 / 120 + t2 * (-1.0 / 5040 + t2 * (1.0 / 362880 + t2 * (-1.0 / 39916800 + t2 * (1.0 / 6227020800.0)))))));
        const double cs = 1.0 + t2 * (-0.5 + t2 * (1.0 / 24 + t2 * (-1.0 / 720 + t2 * (1.0 / 40320 + t2 * (-1.0 / 3628800 + t2 * (1.0 / 479001600.0))))));
        const int qi = ((int)qd) & 3;
        const double c4 = (qi == 0) ? cs : (qi == 1) ? -sn : (qi == 2) ? -cs : sn;
        const double s4 = (qi == 0) ? sn : (qi == 1) ? cs : (qi == 2) ? -sn : -cs;
        F.rope[2 * i] = (float)c4; F.rope[2 * i + 1] = (float)s4;
    }
    for (int m = gw; m < T + NMETA; m += NGW) {
        const float* src = (m < T) ? F.x + (size_t)m * DM : F.meta + (size_t)(m - T) * DM;
        row_to_bf16(src, F.XB + (size_t)m * DM, F.rstd1 + m, lane);
    }
    for (int i = gw * 64 + lane; i < (256 - NMETA) * DM / 8; i += NGW * 64) ((u32x4*)(F.XB + (size_t)(T + NMETA) * DM))[i] = (u32x4){0u, 0u, 0u, 0u};
    for (int i = gw * 64 + lane; i < 256 - NMETA; i += NGW * 64) F.rstd1[T + NMETA + i] = 0.f;
    for (int i = gw * 64 + lane; i < 32 * 16 * 8; i += NGW * 64) { const int bh = i >> 7, r = (i >> 3) & 15, c = i & 7;
        *(u32x4*)(F.KB + ((size_t)bh * LP + LSEQ + r) * HD + c * 8) = (u32x4){0u, 0u, 0u, 0u}; }
    for (int i = gw * 64 + lane; i < 32 * 64 * 2; i += NGW * 64) { const int row = i >> 1, c = i & 1;
        *(u32x4*)(F.VB + (size_t)row * LP + LSEQ + c * 8) = (u32x4){0u, 0u, 0u, 0u}; }
}

struct SchedP1 { int G, c;
    __device__ __forceinline__ bool next(int i, Unit& u) const { const int L = i * G + c; if (L >= 643) return false;
        if (L < 640) { u.pm = L / 5; u.pn = L % 5; } else { u.pm = 128; u.pn = (L == 642) ? 4 : (L - 640); }
        u.ui = 0; u.x0 = 0; u.x1 = 0; u.nv = 256; return true; } };
struct SchedP3 { int G, c;
    __device__ __forceinline__ bool next(int i, Unit& u) const { const int L = i * G + c; if (L >= 512) return false; u.pm = L >> 2; u.pn = L & 3; u.ui = 0; u.x0 = 0; u.x1 = 0; u.nv = 256; return true; } };
struct SchedMoe { const LAS int* hdr;
    __device__ __forceinline__ bool next(int i, Unit& u) const {
        const int n = __builtin_amdgcn_readfirstlane(hdr[MAXU * 8]); if (i >= n) return false;
        u.pm = __builtin_amdgcn_readfirstlane(hdr[i * 8 + 0]); u.pn = __builtin_amdgcn_readfirstlane(hdr[i * 8 + 1]);
        u.x0 = __builtin_amdgcn_readfirstlane(hdr[i * 8 + 2]); u.x1 = __builtin_amdgcn_readfirstlane(hdr[i * 8 + 3]);
        u.nv = __builtin_amdgcn_readfirstlane(hdr[i * 8 + 4]); u.ui = i; return true; } };

struct ProbLinear { static constexpr bool GATHER = false; const bf16_t* A; const bf16_t* Bt; int K, lda, ldb;
    __device__ __forceinline__ const char* a_base(const Unit& u) const { return (const char*)A + (size_t)u.pm * 256 * lda * 2; }
    __device__ __forceinline__ void a_voff(const Unit&, const int (&Rp)[2], const int (&Cp)[2], unsigned (&vo)[2][2]) const {
#pragma unroll
        for (int h = 0; h < 2; ++h)
#pragma unroll
            for (int i = 0; i < 2; ++i) vo[h][i] = (unsigned)((h * 128 + Rp[i]) * lda + Cp[i]) * 2u; }
    __device__ __forceinline__ const char* b_tile(const Unit& u, int kt) const { return (const char*)Bt + (size_t)u.pn * 256 * ldb * 2 + (size_t)kt * 128; } };
struct ProbG1 { static constexpr bool GATHER = true; const bf16_t* A; const bf16_t* Wgu; const LAS int* tokT; int K, lda, ldb;
    __device__ __forceinline__ const char* a_base(const Unit&) const { return (const char*)A; }
    __device__ __forceinline__ void a_voff(const Unit& u, const int (&Rp)[2], const int (&Cp)[2], unsigned (&vo)[2][2]) const {
#pragma unroll
        for (int h = 0; h < 2; ++h)
#pragma unroll
            for (int i = 0; i < 2; ++i) { const int tok = tokT[u.ui * 256 + h * 128 + Rp[i]]; vo[h][i] = (unsigned)(tok * DM + Cp[i]) * 2u; } }
    __device__ __forceinline__ const char* b_tile(const Unit& u, int kt) const { const int e = (u.pn < 2) ? u.x0 : u.x1;
        return (const char*)Wgu + ((size_t)e * 512 + (u.pn & 1) * 256) * DM * 2 + (size_t)kt * 128; } };
struct ProbG2 { static constexpr bool GATHER = false; const bf16_t* A; const bf16_t* Wd; int K, lda, ldb;
    __device__ __forceinline__ const char* a_base(const Unit& u) const { return (const char*)A + (size_t)u.pm * 256 * 512 * 2; }
    __device__ __forceinline__ void a_voff(const Unit&, const int (&Rp)[2], const int (&Cp)[2], unsigned (&vo)[2][2]) const {
#pragma unroll
        for (int h = 0; h < 2; ++h)
#pragma unroll
            for (int i = 0; i < 2; ++i) vo[h][i] = (unsigned)((h * 128 + Rp[i]) * 512 + Cp[i]) * 2u; }
    __device__ __forceinline__ const char* b_tile(const Unit& u, int kt) const { const int e = (kt < 4) ? u.x0 : u.x1;
        return (const char*)Wd + ((size_t)e * DM + u.pn * 256) * DEXP * 2 + (size_t)(kt & 3) * 128; } };

struct EpiP1 { static constexpr bool PERM = true;
    const float* rstd1; const float* rope; const float* qg; const float* kg; bf16_t *UB, *QB, *KB, *VB;
    __device__ __forceinline__ void operator()(const f32x4 (&acc)[2][2][4][2], const Unit& u, int wr, int wc, int fr, int fq) const {
        asm volatile("" : "+v"(fr), "+v"(fq));
        const bool meta = (u.pm == 128);
#pragma unroll
        for (int ai = 0; ai < 2; ++ai)
#pragma unroll
            for (int m = 0; m < 4; ++m) {
                const int rl = ai * 128 + wr * 64 + m * 16 + fr, grow = u.pm * 256 + rl;
                const float rs = rstd1[grow];
                const bool valid = !meta || rl < NMETA;
                const int b = grow >> 11, pos = meta ? rl : (grow & 2047) + NMETA;
                f32x4 v[2][2];
#pragma unroll
                for (int bj = 0; bj < 2; ++bj)
#pragma unroll
                    for (int n = 0; n < 2; ++n) v[bj][n] = acc[ai][bj][m][n] * rs;
                if (u.pn < 2) {
#pragma unroll
                    for (int bj = 0; bj < 2; ++bj) { u32x4 w; w.x = pg8::cvt_pk_bf16(v[bj][0][0], v[bj][0][1]); w.y = pg8::cvt_pk_bf16(v[bj][0][2], v[bj][0][3]); w.z = pg8::cvt_pk_bf16(v[bj][1][0], v[bj][1][1]); w.w = pg8::cvt_pk_bf16(v[bj][1][2], v[bj][1][3]);
                        const int col = u.pn * 256 + bj * 128 + wc * 32 + fq * 8;
                        if (!meta) *(u32x4*)(UB + ((size_t)b * LSEQ + pos) * 512 + col) = w;
                        else if (valid) { for (int bb = 0; bb < NB; ++bb) *(u32x4*)(UB + ((size_t)bb * LSEQ + pos) * 512 + col) = w; } }
                } else {
                    const bool isv = (u.pn == 4) && (wc >= 2);
                    if (!isv) {
                        float ss = 0.f;
#pragma unroll
                        for (int bj = 0; bj < 2; ++bj)
#pragma unroll
                            for (int n = 0; n < 2; ++n) ss += (v[bj][n][0] * v[bj][n][0] + v[bj][n][1] * v[bj][n][1]) + (v[bj][n][2] * v[bj][n][2] + v[bj][n][3] * v[bj][n][3]);
                        ss += __shfl_xor(ss, 16); ss += __shfl_xor(ss, 32);
                        const float rn = 1.0f / sqrtf(ss * (1.0f / HD) + EPS);
                        const float* gp = (u.pn == 4) ? kg : qg;
#pragma unroll
                        for (int bj = 0; bj < 2; ++bj)
#pragma unroll
                            for (int n = 0; n < 2; ++n) { const f32x4 gv = *(const f32x4*)(gp + 32 * bj + 8 * fq + 4 * n); v[bj][n] = v[bj][n] * rn * gv; }
#pragma unroll
                        for (int n = 0; n < 2; ++n) {
                            const f32x4 cs0 = *(const f32x4*)(rope + ((size_t)pos * 8 + 4 * n) * 2), cs1 = *(const f32x4*)(rope + ((size_t)pos * 8 + 4 * n) * 2 + 4);
                            const float c[4] = {cs0[0], cs0[2], cs1[0], cs1[2]}, s[4] = {cs0[1], cs0[3], cs1[1], cs1[3]};
#pragma unroll
                            for (int jj = 0; jj < 4; ++jj) { const float mine = v[0][n][jj], oth = __shfl_xor(mine, 16);
                                const float r = (fq == 0) ? (mine * c[jj] - oth * s[jj]) : (mine * c[jj] + oth * s[jj]);
                                v[0][n][jj] = (fq < 2) ? r : mine; }
                        }
                        if (u.pn != 4) {
#pragma unroll
                            for (int bj = 0; bj < 2; ++bj)
#pragma unroll
                                for (int n = 0; n < 2; ++n) v[bj][n] = v[bj][n] * QSCALE;
                        }
                    }
                    if (isv) {
                        const int pp = (pos & ~15) | (((pos >> 2) & 1) << 3) | (((pos >> 3) & 1) << 2) | (pos & 3); const int hh = wc & 1;
#pragma unroll
                        for (int bj = 0; bj < 2; ++bj)
#pragma unroll
                            for (int n = 0; n < 2; ++n)
#pragma unroll
                                for (int jj = 0; jj < 4; ++jj) { const int d = 32 * bj + 8 * fq + 4 * n + jj; const bf16_t hv = (bf16_t)f2bf(v[bj][n][jj]);
                                    if (!meta) VB[(((size_t)b * 2 + hh) * HD + d) * LP + pp] = hv;
                                    else if (valid) { for (int bb = 0; bb < NB; ++bb) VB[(((size_t)bb * 2 + hh) * HD + d) * LP + pp] = hv; } }
                    } else {
#pragma unroll
                    for (int bj = 0; bj < 2; ++bj) { u32x4 w; w.x = pg8::cvt_pk_bf16(v[bj][0][0], v[bj][0][1]); w.y = pg8::cvt_pk_bf16(v[bj][0][2], v[bj][0][3]); w.z = pg8::cvt_pk_bf16(v[bj][1][0], v[bj][1][1]); w.w = pg8::cvt_pk_bf16(v[bj][1][2], v[bj][1][3]);
                        const int d0 = 32 * bj + 8 * fq;
                        if (u.pn != 4) { const int head = 4 * (u.pn - 2) + wc; *(u32x4*)(QB + (size_t)grow * 512 + head * HD + d0) = w; }
                        else { const int hh = wc & 1;
                            if (!meta) *(u32x4*)(KB + (((size_t)b * 2 + hh) * LP + pos) * HD + d0) = w;
                            else if (valid) { for (int bb = 0; bb < NB; ++bb) *(u32x4*)(KB + (((size_t)bb * 2 + hh) * LP + pos) * HD + d0) = w; } } }
                    }
                }
            }
    }
};
struct EpiP3 { static constexpr bool PERM = true;
    const float* x; bf16_t* H1; float* ss2;
    __device__ __forceinline__ void operator()(const f32x4 (&acc)[2][2][4][2], const Unit& u, int wr, int wc, int fr, int fq) const {
        asm volatile("" : "+v"(fr), "+v"(fq));
#pragma unroll
        for (int ai = 0; ai < 2; ++ai)
#pragma unroll
            for (int m = 0; m < 4; ++m) {
                const int grow = u.pm * 256 + ai * 128 + wr * 64 + m * 16 + fr; float ss = 0.f;
#pragma unroll
                for (int bj = 0; bj < 2; ++bj) { const size_t off = (size_t)grow * DM + u.pn * 256 + bj * 128 + wc * 32 + fq * 8;
                    const f32x4 h0 = *(const f32x4*)(x + off) + acc[ai][bj][m][0], h1 = *(const f32x4*)(x + off + 4) + acc[ai][bj][m][1];
                    ss += (h0[0] * h0[0] + h0[1] * h0[1]) + (h0[2] * h0[2] + h0[3] * h0[3]) + (h1[0] * h1[0] + h1[1] * h1[1]) + (h1[2] * h1[2] + h1[3] * h1[3]);
                    u32x4 w; w.x = pg8::cvt_pk_bf16(h0[0], h0[1]); w.y = pg8::cvt_pk_bf16(h0[2], h0[3]); w.z = pg8::cvt_pk_bf16(h1[0], h1[1]); w.w = pg8::cvt_pk_bf16(h1[2], h1[3]);
                    *(u32x4*)(H1 + off) = w; }
                ss += __shfl_xor(ss, 16); ss += __shfl_xor(ss, 32);
                if (fq == 0) ss2[(size_t)(u.pn * 4 + wc) * T + grow] = ss;
            }
    }
};
struct EpiG1 { static constexpr bool PERM = true;
    bf16_t* HID; const LAS float* rstdT; const LAS float* wloT; const LAS float* whiT;
    __device__ __forceinline__ void operator()(const f32x4 (&acc)[2][2][4][2], const Unit& u, int wr, int wc, int fr, int fq) const {
        asm volatile("" : "+v"(fr), "+v"(fq));
        const LAS float* wT = (u.pn < 2) ? wloT : whiT;
#pragma unroll
        for (int ai = 0; ai < 2; ++ai)
#pragma unroll
            for (int m = 0; m < 4; ++m) {
                const int rl = ai * 128 + wr * 64 + m * 16 + fr; const float rs = rstdT[u.ui * 256 + rl], w = wT[u.ui * 256 + rl];
                float h[8];
#pragma unroll
                for (int n = 0; n < 2; ++n)
#pragma unroll
                    for (int jj = 0; jj < 4; ++jj) { const float g = acc[ai][0][m][n][jj] * rs, up = acc[ai][1][m][n][jj] * rs;
                        h[n * 4 + jj] = g / (1.0f + __expf(-g)) * up * w; }
                u32x4 o; o.x = pg8::cvt_pk_bf16(h[0], h[1]); o.y = pg8::cvt_pk_bf16(h[2], h[3]); o.z = pg8::cvt_pk_bf16(h[4], h[5]); o.w = pg8::cvt_pk_bf16(h[6], h[7]);
                *(u32x4*)(HID + ((size_t)u.pm * 256 + rl) * 512 + u.pn * 128 + wc * 32 + fq * 8) = o;
            }
    }
};
struct EpiG2 { static constexpr bool PERM = false;
    float* out; const bf16_t* H1; const LAS int* tokT;
    __device__ __forceinline__ void operator()(const f32x4 (&acc)[2][2][4][2], const Unit& u, int wr, int wc, int fr, int fq) const {
        asm volatile("" : "+v"(fr), "+v"(fq));
#pragma unroll
        for (int ai = 0; ai < 2; ++ai)
#pragma unroll
            for (int m = 0; m < 4; ++m) {
                const int rl = ai * 128 + wr * 64 + m * 16 + fr; const int tok = tokT[u.ui * 256 + rl];
                if (rl < u.nv) {
#pragma unroll
                    for (int bj = 0; bj < 2; ++bj)
#pragma unroll
                        for (int n = 0; n < 2; ++n) { const size_t off = (size_t)tok * DM + u.pn * 256 + bj * 128 + wc * 32 + n * 16 + fq * 4;
                            const u32x2 hb = *(const u32x2*)(H1 + off);
                            f32x4 o = acc[ai][bj][m][n]; o[0] += bflo(hb.x); o[1] += bfhi(hb.x); o[2] += bflo(hb.y); o[3] += bfhi(hb.y);
                            *(f32x4*)(out + off) = o; }
                }
            }
    }
};

__device__ __forceinline__ void p2_pool(Frame& F) {
    const int gw = F.vcu * 8 + F.wave, NGW = F.G * 8, lane = F.lane;
    const int g = lane >> 4, w = 2 << g; const float invw = 1.0f / (float)w;
    for (int task = gw; task < T / 16; task += NGW) {
        const int m0 = task * 16, b = m0 >> 11, pos0 = (m0 & 2047) + NMETA;
        const bf16_t* up = F.UB + ((size_t)b * LSEQ + pos0) * 512 + lane * 8;
        float a[8];
#pragma unroll
        for (int j = 0; j < 8; ++j) a[j] = 0.f;
        for (int i = 1; i < w; ++i) { const u32x4 q = *(const u32x4*)(up - (size_t)i * 512);
            a[0] += bflo(q.x); a[1] += bfhi(q.x); a[2] += bflo(q.y); a[3] += bfhi(q.y); a[4] += bflo(q.z); a[5] += bfhi(q.z); a[6] += bflo(q.w); a[7] += bfhi(q.w); }
#pragma unroll 4
        for (int t = 0; t < 16; ++t) {
            const u32x4 nw = *(const u32x4*)(up + (size_t)t * 512);
            a[0] += bflo(nw.x); a[1] += bfhi(nw.x); a[2] += bflo(nw.y); a[3] += bfhi(nw.y); a[4] += bflo(nw.z); a[5] += bfhi(nw.z); a[6] += bflo(nw.w); a[7] += bfhi(nw.w);
            u32x4 o;
            o.x = pk2(a[0] * invw - bflo(nw.x), a[1] * invw - bfhi(nw.x)); o.y = pk2(a[2] * invw - bflo(nw.y), a[3] * invw - bfhi(nw.y));
            o.z = pk2(a[4] * invw - bflo(nw.z), a[5] * invw - bfhi(nw.z)); o.w = pk2(a[6] * invw - bflo(nw.w), a[7] * invw - bfhi(nw.w));
            *(u32x4*)(F.YMIX + (size_t)(m0 + t) * DM + lane * 8) = o;
            const u32x4 od = *(const u32x4*)(up + (long)(t - (w - 1)) * 512);
            a[0] -= bflo(od.x); a[1] -= bfhi(od.x); a[2] -= bflo(od.y); a[3] -= bfhi(od.y); a[4] -= bflo(od.z); a[5] -= bfhi(od.z); a[6] -= bflo(od.w); a[7] -= bfhi(od.w);
        }
    }
}
typedef float f32x16 __attribute__((ext_vector_type(16)));
template <int MODE>
__device__ __forceinline__ void attn_tile(f32x16& o0, f32x16& o1, float& l, const bf16x8 (&qf)[4], const bf16_t* kr, const bf16_t* vr, float cinit, int x, int thr, bool ex) {
    f32x16 s;
#pragma unroll
    for (int r = 0; r < 16; ++r) s[r] = cinit;
#pragma unroll
    for (int ks = 0; ks < 4; ++ks) { const bf16x8 kf = *(const bf16x8*)(kr + 16 * ks); s = __builtin_amdgcn_mfma_f32_32x32x16_bf16(kf, qf[ks], s, 0, 0, 0); }
    float e[16];
#pragma unroll
    for (int r = 0; r < 16; ++r) {
        const int c = (r & 3) + 8 * (r >> 2);
        float v = __builtin_amdgcn_exp2f(s[r]);
        if (MODE == 1) { bool vis = (x - c) < thr; if (r < 8) vis = vis || ex; v = vis ? v : 0.f; }
        if (MODE == 2) { const bool vis = (x - c) >= thr; v = vis ? v : 0.f; }
        if (MODE == 3) { if (r >= 8) v = 0.f; }
        e[r] = v; l += v;
    }
    bf16x8 pf0, pf1;
    { u32x4 w0, w1;
      w0.x = pg8::cvt_pk_bf16(e[0], e[1]); w0.y = pg8::cvt_pk_bf16(e[2], e[3]); w0.z = pg8::cvt_pk_bf16(e[4], e[5]); w0.w = pg8::cvt_pk_bf16(e[6], e[7]);
      w1.x = pg8::cvt_pk_bf16(e[8], e[9]); w1.y = pg8::cvt_pk_bf16(e[10], e[11]); w1.z = pg8::cvt_pk_bf16(e[12], e[13]); w1.w = pg8::cvt_pk_bf16(e[14], e[15]);
      pf0 = __builtin_bit_cast(bf16x8, w0); pf1 = __builtin_bit_cast(bf16x8, w1); }
    { const bf16x8 v00 = *(const bf16x8*)(vr), v10 = *(const bf16x8*)(vr + (size_t)32 * LP);
      o0 = __builtin_amdgcn_mfma_f32_32x32x16_bf16(v00, pf0, o0, 0, 0, 0); o1 = __builtin_amdgcn_mfma_f32_32x32x16_bf16(v10, pf0, o1, 0, 0, 0); }
    if (MODE != 3) { const bf16x8 v01 = *(const bf16x8*)(vr + 16), v11 = *(const bf16x8*)(vr + (size_t)32 * LP + 16);
      o0 = __builtin_amdgcn_mfma_f32_32x32x16_bf16(v01, pf1, o0, 0, 0, 0); o1 = __builtin_amdgcn_mfma_f32_32x32x16_bf16(v11, pf1, o1, 0, 0, 0); }
}
__device__ __forceinline__ void p2_attn(Frame& F) {
    const int lane = F.lane, wave = F.wave, r = lane & 31, h = lane >> 5;
    const float gq = wave_max(fabsf(F.qg[lane])), gk = wave_max(fabsf(F.kg[lane]));
    const float cb = 8.0f * LOG2E * gq * gk * 1.01f;
    const int x = r - 4 * h;
    for (int bt = F.vcu; bt < NB * NKVH * 32; bt += F.G) {
        const int b = bt >> 6, kvh = (bt >> 5) & 1, qt = 2 * (bt & 31) + (wave >> 2), hq = wave & 3, head = kvh * 4 + hq;
        const int m0 = b * SEQ + 32 * qt;
        const bf16_t* qp = F.QB + (size_t)(m0 + r) * 512 + head * HD + 8 * h;
        bf16x8 qf[4];
#pragma unroll
        for (int ks = 0; ks < 4; ++ks) qf[ks] = *(const bf16x8*)(qp + 16 * ks);
        const bf16_t* Kp = F.KB + ((size_t)b * 2 + kvh) * LP * HD + (size_t)r * HD + 8 * h;
        const bf16_t* Vp = F.VB + (((size_t)b * 2 + kvh) * HD + r) * LP + 8 * h;
        f32x16 o0, o1;
#pragma unroll
        for (int i = 0; i < 16; ++i) { o0[i] = 0.f; o1[i] = 0.f; }
        float l = 0.f;
        const float NEG = -1.0e30f;
        attn_tile<3>(o0, o1, l, qf, Kp, Vp, (qt >= 5) ? -cb : NEG, x, 0, false);
        { const int kt = qt - 4, kc = kt < 0 ? 0 : kt; attn_tile<1>(o0, o1, l, qf, Kp + (size_t)kc * 32 * HD, Vp + kc * 32, kt >= 0 ? -cb : NEG, x, -16, kt == 0); }
        { const int kt = qt - 3, kc = kt < 0 ? 0 : kt; attn_tile<1>(o0, o1, l, qf, Kp + (size_t)kc * 32 * HD, Vp + kc * 32, kt >= 0 ? -cb : NEG, x, 16, kt == 0); }
        { const int kt = qt - 2, kc = kt < 0 ? 0 : kt; attn_tile<0>(o0, o1, l, qf, Kp + (size_t)kc * 32 * HD, Vp + kc * 32, kt >= 0 ? -cb : NEG, x, 0, false); }
        { const int kt = qt - 1, kc = kt < 0 ? 0 : kt; attn_tile<0>(o0, o1, l, qf, Kp + (size_t)kc * 32 * HD, Vp + kc * 32, kt >= 0 ? -cb : NEG, x, 0, false); }
        { const int kt = qt;                           attn_tile<2>(o0, o1, l, qf, Kp + (size_t)kt * 32 * HD, Vp + kt * 32, -cb, x, -16, false); }
        { const int kt = qt + 1;                       attn_tile<2>(o0, o1, l, qf, Kp + (size_t)kt * 32 * HD, Vp + kt * 32, -cb, x, 16, false); }
        l += __shfl_xor(l, 32);
        l += __builtin_amdgcn_exp2f(F.sinks[head] * LOG2E - cb);
        const float inv = 1.0f / l;
        bf16_t* op = F.YMIX + (size_t)(m0 + r) * DM + 512 + head * HD + 4 * h;
#pragma unroll
        for (int g4 = 0; g4 < 4; ++g4) {
            u32x2 w0, w1;
            w0.x = pg8::cvt_pk_bf16(o0[4 * g4] * inv, o0[4 * g4 + 1] * inv); w0.y = pg8::cvt_pk_bf16(o0[4 * g4 + 2] * inv, o0[4 * g4 + 3] * inv);
            w1.x = pg8::cvt_pk_bf16(o1[4 * g4] * inv, o1[4 * g4 + 1] * inv); w1.y = pg8::cvt_pk_bf16(o1[4 * g4 + 2] * inv, o1[4 * g4 + 3] * inv);
            *(u32x2*)(op + 8 * g4) = w0; *(u32x2*)(op + 32 + 8 * g4) = w1;
        }
    }
}

__device__ __forceinline__ void p4_route(Frame& F) {
    const int lane = F.lane, wave = F.wave, tid = F.tid;
    LAS float* lg = (LAS float*)(F.lds) + wave * 512;
    LAS int* hist = (LAS int*)(F.lds + 32768);
    for (int chunk = F.vcu; chunk < T / 128; chunk += F.G) {
        if (tid < 48) hist[tid] = 0;
        __syncthreads();
        const int tok0 = chunk * 128 + wave * 16;
        f32x4 a0 = {0.f, 0.f, 0.f, 0.f}, a1 = {0.f, 0.f, 0.f, 0.f};
        const bf16_t* hp = F.H1 + (size_t)(tok0 + (lane & 15)) * DM + 8 * (lane >> 4);
        const bf16_t* wp = F.Wr_t + (size_t)(lane & 15) * DM + 8 * (lane >> 4);
#pragma unroll 8
        for (int kk = 0; kk < 32; ++kk) { const bf16x8 a = *(const bf16x8*)(hp + kk * 32), b0 = *(const bf16x8*)(wp + kk * 32), b1 = *(const bf16x8*)(wp + 16 * DM + kk * 32);
            a0 = __builtin_amdgcn_mfma_f32_16x16x32_bf16(a, b0, a0, 0, 0, 0); a1 = __builtin_amdgcn_mfma_f32_16x16x32_bf16(a, b1, a1, 0, 0, 0); }
#pragma unroll
        for (int r = 0; r < 4; ++r) { lg[(4 * (lane >> 4) + r) * 32 + (lane & 15)] = a0[r]; lg[(4 * (lane >> 4) + r) * 32 + 16 + (lane & 15)] = a1[r]; }
        LDS_WAIT(); asm volatile("" ::: "memory");
        int p = 0, rank = 0; float wlo = 0.f, whi = 0.f, rs = 0.f; const int tok = tok0 + lane;
        if (lane < 16) {
            float ss = 0.f;
#pragma unroll
            for (int q = 0; q < 16; ++q) ss += F.ss2[(size_t)q * T + tok];
            rs = 1.0f / sqrtf(ss * (1.0f / DM) + EPS);
            const LAS float* l = lg + lane * 32;
            const float g0 = l[16] * rs, g1 = l[17] * rs, g2 = l[18] * rs, g3 = l[19] * rs;
            int gi = 0; float gm = g0; if (g1 > gm) { gm = g1; gi = 1; } if (g2 > gm) { gm = g2; gi = 2; } if (g3 > gm) { gm = g3; gi = 3; }
            const float gprob = 1.0f / (expf(g0 - gm) + expf(g1 - gm) + expf(g2 - gm) + expf(g3 - gm));
            const float e0 = l[gi * 4 + 0] * rs, e1 = l[gi * 4 + 1] * rs, e2 = l[gi * 4 + 2] * rs, e3 = l[gi * 4 + 3] * rs;
            int i1 = 0; float v1 = e0; if (e1 > v1) { v1 = e1; i1 = 1; } if (e2 > v1) { v1 = e2; i1 = 2; } if (e3 > v1) { v1 = e3; i1 = 3; }
            int i2 = -1; float v2 = -3.0e38f;
            if (i1 != 0 && e0 > v2) { v2 = e0; i2 = 0; } if (i1 != 1 && e1 > v2) { v2 = e1; i2 = 1; } if (i1 != 2 && e2 > v2) { v2 = e2; i2 = 2; } if (i1 != 3 && e3 > v2) { v2 = e3; i2 = 3; }
            const float p1 = 1.0f / (1.0f + expf(v2 - v1)), p2 = 1.0f - p1;
            const float w1 = p1 * gprob, w2 = p2 * gprob;
            const int lo = i1 < i2 ? i1 : i2, hi = i1 < i2 ? i2 : i1;
            wlo = i1 < i2 ? w1 : w2; whi = i1 < i2 ? w2 : w1;
            const int pidx = (lo == 0) ? (hi - 1) : (lo == 1 ? hi + 1 : 5);
            p = gi * 6 + pidx;
            rank = __hip_atomic_fetch_add(&hist[p], 1, __ATOMIC_RELAXED, __HIP_MEMORY_SCOPE_WORKGROUP);
        }
        __syncthreads();
        if (tid < NPAIR) hist[24 + tid] = (int)atomicAdd(F.ctl + CW_CNT + tid, (unsigned)hist[tid]);
        __syncthreads();
        if (lane < 16) { const int slot = hist[24 + p] + rank; F.list[(size_t)p * T + slot] = tok; F.rstd2[tok] = rs; F.wlo[tok] = wlo; F.whi[tok] = whi; }
        __syncthreads();
    }
}
__device__ __forceinline__ void moe_tables(Frame& F) {
    LAS int* tokT = (LAS int*)(F.lds + TAB_TOK); LAS float* rstdT = (LAS float*)(F.lds + TAB_RSTD); LAS float* wloT = (LAS float*)(F.lds + TAB_WLO); LAS float* whiT = (LAS float*)(F.lds + TAB_WHI);
    LAS int* hdr = (LAS int*)(F.lds + TAB_HDR); LAS int* pre = hdr + 64;
    const int tid = F.tid;
    if (tid < NPAIR) pre[32 + tid] = (int)__hip_atomic_load(F.ctl + CW_CNT + tid, __ATOMIC_RELAXED, __HIP_MEMORY_SCOPE_AGENT);
    __syncthreads();
    if (tid == 0) { int s = 0; for (int p = 0; p < NPAIR; ++p) { pre[p] = s; s += (pre[32 + p] + 255) >> 8; } pre[NPAIR] = s; }
    __syncthreads();
    const int NT = pre[NPAIR];
    int nu = 0;
    for (int ui = 0; ui < MAXU; ++ui) {
        const int L = ui * F.G + F.vcu; if (L >= 4 * NT) break;
        const int rt = L >> 2, j = L & 3; int p = 0;
        for (int q = 0; q < NPAIR; ++q) if (pre[q] <= rt && rt < pre[q + 1]) p = q;
        const int t = rt - pre[p], cntp = pre[32 + p]; const int nv = (cntp - 256 * t) < 256 ? (cntp - 256 * t) : 256;
        const int g = p / 6, pi = p % 6; const int lo = (pi < 3) ? 0 : (pi < 5 ? 1 : 2); const int hi = (pi < 3) ? pi + 1 : (pi < 5 ? pi - 1 : 3);
        if (tid == 0) { hdr[ui * 8 + 0] = rt; hdr[ui * 8 + 1] = j; hdr[ui * 8 + 2] = g * 4 + lo; hdr[ui * 8 + 3] = g * 4 + hi; hdr[ui * 8 + 4] = nv; }
        if (tid < 256) { const int r = tid < nv ? tid : 0; const int tok = F.list[(size_t)p * T + 256 * t + r];
            tokT[ui * 256 + tid] = tok; rstdT[ui * 256 + tid] = F.rstd2[tok]; wloT[ui * 256 + tid] = tid < nv ? F.wlo[tok] : 0.f; whiT[ui * 256 + tid] = tid < nv ? F.whi[tok] : 0.f; }
        ++nu;
    }
    if (tid == 0) hdr[MAXU * 8] = nu;
    __syncthreads();
}

struct Args { const float* in[16]; float* out; unsigned char* ws; int ph_lo, ph_hi; };
constexpr int N_LAUNCHES = MK_N_LAUNCHES;
constexpr int PER_PHASE = 7;

__global__ void __launch_bounds__(512, 2) hymba_fwd(Args args) {
    extern __shared__ __attribute__((aligned(16))) unsigned char lds[];
    Frame F;
    F.lds = (LAS unsigned char*)lds;
    F.MISC = (volatile LAS unsigned*)(F.lds + MISC_OFF);
    F.tid = threadIdx.x; F.lane = F.tid & 63; F.wave = __builtin_amdgcn_readfirstlane(F.tid >> 6);
    F.G = gridDim.x; { const int bx = blockIdx.x; F.vcu = (F.G % 8 == 0) ? (bx % 8) * (F.G / 8) + bx / 8 : bx; }
    unsigned char* ws = args.ws;
    F.ctl = (unsigned*)(ws + WS_CTL);
    F.x = args.in[0]; F.meta = args.in[1]; F.g1 = args.in[2]; F.win = args.in[3]; F.wpool = args.in[4]; F.pscale = args.in[5]; F.qg = args.in[6]; F.kg = args.in[7];
    F.sinks = args.in[8]; F.wout = args.in[9]; F.g2 = args.in[10]; F.wgr = args.in[11]; F.wer = args.in[12]; F.wgate = args.in[13]; F.wup = args.in[14]; F.wdown = args.in[15];
    F.out = args.out;
    F.Win_t = (bf16_t*)(ws + WS_WIN); F.Wout_t = (bf16_t*)(ws + WS_WOUT); F.Wgu_t = (bf16_t*)(ws + WS_WGU); F.Wd_t = (bf16_t*)(ws + WS_WD); F.Wr_t = (bf16_t*)(ws + WS_WR);
    F.XB = (bf16_t*)(ws + WS_XB); F.UB = (bf16_t*)(ws + WS_U); F.QB = (bf16_t*)(ws + WS_Q); F.KB = (bf16_t*)(ws + WS_K); F.VB = (bf16_t*)(ws + WS_V);
    F.YMIX = (bf16_t*)(ws + WS_YMIX); F.H1 = (bf16_t*)(ws + WS_H1); F.HID = (bf16_t*)(ws + WS_HID);
    F.rope = (float*)(ws + WS_ROPE); F.rstd1 = (float*)(ws + WS_RSTD1); F.rstd2 = (float*)(ws + WS_RSTD2); F.wlo = (float*)(ws + WS_WLO); F.whi = (float*)(ws + WS_WHI); F.ss2 = (float*)(ws + WS_SS2);
    F.list = (int*)(ws + WS_LIST);
    for (int u = F.tid; u < (LDS_BYTES - TAB_HDR) / 4; u += 512) ((LAS unsigned*)(F.lds + TAB_HDR))[u] = 0u;
    __syncthreads();
    XcdBarrier bar; bar.bar = (unsigned*)(F.ctl + CW_BAR); bar.x = 0; bar.st = nullptr;
    if (N_LAUNCHES == 1) bar = xcd_barrier_post((unsigned*)(F.ctl + CW_BAR), F.MISC + 8);
    const int lo = args.ph_lo, hi = args.ph_hi;
#ifndef PHASE_MASK
#define PHASE_MASK 0x7f
#endif
#define IN(k) (((PHASE_MASK >> (k)) & 1) && lo <= (k) && (k) < hi)
#define BOTH(k) (IN(k) && IN((k) + 1))
#define GRID_BAR() do { if (N_LAUNCHES == 1) xcd_barrier(bar); } while (0)
#ifndef REPEAT_MASK
#define REPEAT_MASK 0
#endif
#define REP(k) for (int rep_ = 0; rep_ < (((REPEAT_MASK >> (k)) & 1) ? 2 : 1); ++rep_)

    if (IN(0)) { REP(0) { p0_prologue(F); } if (BOTH(0)) GRID_BAR(); }

    if (IN(1)) {
        ProbLinear P{F.XB, F.Win_t, DM, DM, DM}; SchedP1 S{F.G, F.vcu};
        EpiP1 E{F.rstd1, F.rope, F.qg, F.kg, F.UB, F.QB, F.KB, F.VB};
        REP(1) { pg8::gemm_phase(F.lds, P, S, E); }
        if (BOTH(1)) GRID_BAR();
    }
    if (IN(2)) { REP(2) { p2_pool(F); } REP(7) { p2_attn(F); } if (BOTH(2)) GRID_BAR(); }
    if (IN(3)) {
        ProbLinear P{F.YMIX, F.Wout_t, DM, DM, DM}; SchedP3 S{F.G, F.vcu};
        EpiP3 E{F.x, F.H1, F.ss2};
        REP(3) { pg8::gemm_phase(F.lds, P, S, E); }
        if (BOTH(3)) GRID_BAR();
    }
    if (IN(4)) { p4_route(F); if (BOTH(4)) GRID_BAR(); }
    if (IN(5)) {
        moe_tables(F);
        ProbG1 P{F.H1, F.Wgu_t, (const LAS int*)(F.lds + TAB_TOK), DM, DM, DM}; SchedMoe S{(const LAS int*)(F.lds + TAB_HDR)};
        EpiG1 E{F.HID, (const LAS float*)(F.lds + TAB_RSTD), (const LAS float*)(F.lds + TAB_WLO), (const LAS float*)(F.lds + TAB_WHI)};
        REP(5) { pg8::gemm_phase(F.lds, P, S, E); }
        if (BOTH(5)) GRID_BAR();
    }
    if (IN(6)) {
        if (!IN(5)) moe_tables(F);
        ProbG2 P{F.HID, F.Wd_t, 512, 512, DEXP}; SchedMoe S{(const LAS int*)(F.lds + TAB_HDR)};
        EpiG2 E{F.out, F.H1, (const LAS int*)(F.lds + TAB_TOK)};
        REP(6) { pg8::gemm_phase(F.lds, P, S, E); }
    }
#undef IN
#undef BOTH
}

extern "C" void kernel_launch(void* const* d_in, const int* in_sizes, int n_in, void* d_out, int out_size, void* d_ws, size_t ws_size, hipStream_t stream) {
    static int grid = 0;
    if (grid == 0) {
        if (n_in != 16 || in_sizes[0] != T * DM || out_size != T * DM || ws_size < WS_END) { fprintf(stderr, "kernel_launch: unexpected shapes (n_in %d, in0 %d, out %d, ws %zu)\n", n_in, n_in > 0 ? in_sizes[0] : -1, out_size, ws_size); grid = -1; return; }
        int dev = 0, cus = 0, per_cu = 0;
        if (hipGetDevice(&dev) != hipSuccess || hipDeviceGetAttribute(&cus, hipDeviceAttributeMultiprocessorCount, dev) != hipSuccess) { grid = -1; return; }
        if (hipFuncSetAttribute((const void*)hymba_fwd, hipFuncAttributeMaxDynamicSharedMemorySize, LDS_BYTES) != hipSuccess) { fprintf(stderr, "kernel_launch: hipFuncSetAttribute failed\n"); grid = -1; return; }
        if (hipOccupancyMaxActiveBlocksPerMultiprocessor(&per_cu, (const void*)hymba_fwd, 512, LDS_BYTES) != hipSuccess || per_cu < 1)
            fprintf(stderr, "kernel_launch: occupancy query reports %d workgroups per CU\n", per_cu);
        (void)hipGetLastError();
        grid = cus;
    }
    if (grid < 0) return;
    if (hipMemsetAsync((char*)d_ws + WS_CTL, 0, CTL_ZERO_BYTES, stream) != hipSuccess) { fprintf(stderr, "kernel_launch: memset failed\n"); return; }
    Args a{};
    for (int i = 0; i < 16; ++i) a.in[i] = (const float*)d_in[i];
    a.out = (float*)d_out; a.ws = (unsigned char*)d_ws;
    for (int li = 0; li < N_LAUNCHES; ++li) {
        a.ph_lo = (N_LAUNCHES == PER_PHASE) ? li : 0; a.ph_hi = (N_LAUNCHES == PER_PHASE) ? li + 1 : PER_PHASE;
        hipLaunchKernelGGL(hymba_fwd, dim3(grid), dim3(512), LDS_BYTES, stream, a);
        const hipError_t le = hipPeekAtLastError();
        if (le != hipSuccess) { fprintf(stderr, "kernel_launch: launch %d failed: %s\n", li, hipGetErrorName(le)); break; }
    }
}
```

```cpp
#include <hip/hip_runtime.h>
#include <cstdio>
#include <cstdint>

#ifndef MK_N_LAUNCHES
#define MK_N_LAUNCHES 1
#endif

#define LAS __attribute__((address_space(3)))
#define GAS __attribute__((address_space(1)))
typedef unsigned short bf16_t;
typedef short bf16x8 __attribute__((ext_vector_type(8)));
typedef float f32x4 __attribute__((ext_vector_type(4)));
typedef float f32x2 __attribute__((ext_vector_type(2)));
typedef unsigned u32x4 __attribute__((ext_vector_type(4)));
typedef unsigned u32x2 __attribute__((ext_vector_type(2)));

constexpr int DM = 1024, NB = 16, SEQ = 2048, NMETA = 16, LSEQ = SEQ + NMETA, LP = 2080;
constexpr int T = NB * SEQ;
constexpr int TM = T + 256;
constexpr int INW = 1280, NHEAD = 8, NKVH = 2, HD = 64, NEXP = 16, DEXP = 256, NPAIR = 24;
constexpr float EPS = 1e-6f;
constexpr float LOG2E = 1.4426950408889634f, QSCALE = 0.125f * LOG2E;
constexpr int MAXU = 4;

constexpr size_t MiB = 1u << 20;
constexpr size_t WS_CTL = 0, CTL_ZERO_BYTES = 1 * MiB;
constexpr size_t WS_WIN = 2 * MiB;
constexpr size_t WS_WOUT = 5 * MiB;
constexpr size_t WS_WGU = 8 * MiB;
constexpr size_t WS_WD = 24 * MiB;
constexpr size_t WS_WR = 32 * MiB;
constexpr size_t WS_ROPE = 33 * MiB;
constexpr size_t WS_RSTD1 = 34 * MiB;
constexpr size_t WS_RSTD2 = 35 * MiB;
constexpr size_t WS_WLO = 36 * MiB, WS_WHI = 37 * MiB;
constexpr size_t WS_SS2 = 38 * MiB;
constexpr size_t WS_LIST = 40 * MiB;
constexpr size_t WS_K = 44 * MiB;
constexpr size_t WS_V = 53 * MiB;
constexpr size_t WS_XB = 64 * MiB;
constexpr size_t WS_U = 130 * MiB;
constexpr size_t WS_Q = 164 * MiB;
constexpr size_t WS_YMIX = 196 * MiB;
constexpr size_t WS_H1 = 260 * MiB;
constexpr size_t WS_HID = 324 * MiB;
constexpr size_t WS_END = 364 * MiB;
constexpr int CW_CNT = 64;
constexpr int CW_BAR = 4096;

constexpr int RING_BYTES = 131072;
constexpr int TAB_OFF = RING_BYTES;
constexpr int TAB_TOK = TAB_OFF;
constexpr int TAB_RSTD = TAB_TOK + MAXU * 1024;
constexpr int TAB_WLO = TAB_RSTD + MAXU * 1024;
constexpr int TAB_WHI = TAB_WLO + MAXU * 1024;
constexpr int TAB_HDR = TAB_WHI + MAXU * 1024;
constexpr int MISC_OFF = TAB_HDR + 1024;
constexpr int LDS_BYTES = MISC_OFF + 128;
static_assert(LDS_BYTES <= 163840, "LDS map");

#define LDS_WAIT() asm volatile("s_waitcnt lgkmcnt(0)" ::: "memory")
#define VM_WAIT() asm volatile("s_waitcnt vmcnt(0)" ::: "memory")
__device__ __forceinline__ unsigned f2bf(float f) { unsigned u = __builtin_bit_cast(unsigned, f); return (u + 0x7fffu + ((u >> 16) & 1u)) >> 16; }
__device__ __forceinline__ unsigned pk2(float lo, float hi) { return f2bf(lo) | (f2bf(hi) << 16); }
__device__ __forceinline__ float bflo(unsigned w) { return __builtin_bit_cast(float, w << 16); }
__device__ __forceinline__ float bfhi(unsigned w) { return __builtin_bit_cast(float, w & 0xffff0000u); }
__device__ __forceinline__ float bf1(bf16_t h) { return __builtin_bit_cast(float, (unsigned)h << 16); }
__device__ __forceinline__ float wave_sum(float v) {
#pragma unroll
    for (int o = 1; o < 64; o <<= 1) v += __shfl_xor(v, o);
    return v;
}
__device__ __forceinline__ float wave_max(float v) {
#pragma unroll
    for (int o = 1; o < 64; o <<= 1) v = fmaxf(v, __shfl_xor(v, o));
    return v;
}

namespace pg8 {
constexpr int BM = 256, BK = 64, HALF = 128, HTB = HALF * BK * 2, STAGE_BYTES = 8 * HTB;
__host__ __device__ __forceinline__ int lds_byte(int r, int c) { const int st = (r >> 4) * 2 + (c >> 5), rr = r & 15, cc = c & 31, ob = rr * 64 + cc * 2; return st * 1024 + (ob ^ (((ob >> 9) & 1) << 5)); }
__host__ __device__ __forceinline__ void stage_rc(int b, int& R, int& C) { const int st = b / 1024, sb = b % 1024, swz = sb ^ (((sb >> 9) & 1) << 5); R = (st >> 1) * 16 + swz / 64; C = (st & 1) * 32 + (swz % 64) / 2; }
__host__ __device__ __forceinline__ int perm32(int rho) { const int n = rho >> 4, i = rho & 15; return 8 * (i >> 2) + 4 * n + (i & 3); }

struct Unit { int pm, pn, ui, x0, x1, nv; };
__device__ __forceinline__ unsigned cvt_pk_bf16(float lo, float hi) { unsigned r; asm volatile("v_cvt_pk_bf16_f32 %0, %1, %2" : "=v"(r) : "v"(lo), "v"(hi)); return r; }

template <class Prob, class Epi, class Sched>
__device__ __forceinline__ void gemm_phase(LAS unsigned char* lds, const Prob& P, const Sched& S, const Epi& E) {
    int tid_ = threadIdx.x; asm volatile("" : "+v"(tid_));
    const int tid = tid_, wid = __builtin_amdgcn_readfirstlane(tid >> 6), lane = tid & 63, wr = wid >> 2, wc = wid & 3, fr = lane & 15, fq = lane >> 4;
    const int nt = P.K / BK;
    int Rp[2], Cp[2]; unsigned voffB[2];
#pragma unroll
    for (int i = 0; i < 2; ++i) { stage_rc(tid * 16 + i * 8192, Rp[i], Cp[i]); const int Rb = Epi::PERM ? ((Rp[i] & ~31) + perm32(Rp[i] & 31)) : Rp[i];
        voffB[i] = (unsigned)(Rb * P.ldb + Cp[i]) * 2u; }
    const size_t kstep = (size_t)(BK * 2);
    const size_t hstepB = (size_t)HALF * P.ldb * 2;
    const unsigned ldsw = (unsigned)wid * 1024u;
    const int aoff = lds_byte(wr * 64 + fr, fq * 8), boff = lds_byte(wc * 32 + fr, fq * 8);
#define PG8_SA(b, h) (((b) * 2 + (h)) * HTB)
#define PG8_SB(b, h) ((4 + (b) * 2 + (h)) * HTB)
#define PG8_STAGE(bufoff, gbase, voff) do { _Pragma("unroll") for (int _i = 0; _i < 2; ++_i) \
        __builtin_amdgcn_global_load_lds((const unsigned*)((const char*)(gbase) + (voff)[_i]), (LAS unsigned*)(lds + (bufoff) + ldsw + _i * 8192), 16, 0, 0); } while (0)
#define PG8_LDA(dst, b, h) do { _Pragma("unroll") for (int m = 0; m < 4; ++m) _Pragma("unroll") for (int k = 0; k < 2; ++k) dst[m][k] = *(const LAS bf16x8*)(lds + PG8_SA(b, h) + aoff + m * 2048 + k * 1024); } while (0)
#define PG8_LDB(dst, b, h) do { _Pragma("unroll") for (int n = 0; n < 2; ++n) _Pragma("unroll") for (int k = 0; k < 2; ++k) dst[n][k] = *(const LAS bf16x8*)(lds + PG8_SB(b, h) + boff + n * 2048 + k * 1024); } while (0)
#define PG8_MMA(ai, bj, At, Bt) do { __builtin_amdgcn_s_setprio(1); _Pragma("unroll") for (int m = 0; m < 4; ++m) _Pragma("unroll") for (int n = 0; n < 2; ++n) _Pragma("unroll") for (int k = 0; k < 2; ++k) \
        acc[ai][bj][m][n] = __builtin_amdgcn_mfma_f32_16x16x32_bf16(Bt[n][k], At[m][k], acc[ai][bj][m][n], 0, 0, 0); __builtin_amdgcn_s_setprio(0); } while (0)
#define PG8_WAIT_V(n) asm volatile("s_waitcnt vmcnt(" #n ")" ::: "memory")
#define PG8_WAIT_L(n) asm volatile("s_waitcnt lgkmcnt(" #n ")" ::: "memory")
#define PG8_BAR __builtin_amdgcn_s_barrier()
#define PG8_SCHED __builtin_amdgcn_sched_barrier(0)
    Unit cur, nxt; int ui = 0;
    if (!S.next(0, cur)) return;
    f32x4 acc[2][2][4][2];
#pragma unroll
    for (int a = 0; a < 2; ++a)
#pragma unroll
        for (int b = 0; b < 2; ++b)
#pragma unroll
            for (int m = 0; m < 4; ++m)
#pragma unroll
                for (int n = 0; n < 2; ++n) acc[a][b][m][n] = (f32x4){0.f, 0.f, 0.f, 0.f};
    bf16x8 At[4][2], B0[2][2], B1[2][2];
    unsigned voC[2][2], voN[2][2];
    P.a_voff(cur, Rp, Cp, voC);
    const char* cA = P.a_base(cur);
    {
        const char* b0 = P.b_tile(cur, 0); const char* b1 = P.b_tile(cur, 1);
        PG8_STAGE(PG8_SB(0, 0), b0, voffB); PG8_STAGE(PG8_SB(0, 1), b0 + hstepB, voffB); PG8_STAGE(PG8_SA(0, 0), cA, voC[0]); PG8_STAGE(PG8_SA(0, 1), cA, voC[1]);
        if (wr == 1) PG8_BAR;
        PG8_WAIT_V(2); PG8_BAR;
        PG8_STAGE(PG8_SB(1, 0), b1, voffB); PG8_STAGE(PG8_SA(1, 0), cA + kstep, voC[0]); PG8_STAGE(PG8_SB(1, 1), b1 + hstepB, voffB);
        PG8_WAIT_V(6); PG8_BAR;
    }
    for (;;) {
        const bool has_next = S.next(ui + 1, nxt);
        if (!has_next) nxt = cur;
        if constexpr (Prob::GATHER) P.a_voff(nxt, Rp, Cp, voN);
        const char* nA = P.a_base(nxt);
#pragma clang loop unroll(disable)
        for (int t = 0; t < nt; t += 2) {
            const bool last = (t == nt - 2);
            const char* a1 = cA + (size_t)(t + 1) * kstep;
            const char* a2 = last ? nA : cA + (size_t)(t + 2) * kstep;
            const char* a3 = a2 + kstep;
            const char* b2 = last ? P.b_tile(nxt, 0) : P.b_tile(cur, t + 2);
            const char* b3 = last ? P.b_tile(nxt, 1) : P.b_tile(cur, t + 3);
            unsigned v2[2][2];
#pragma unroll
            for (int h = 0; h < 2; ++h)
#pragma unroll
                for (int i = 0; i < 2; ++i) { if constexpr (Prob::GATHER) v2[h][i] = last ? voN[h][i] : voC[h][i]; else v2[h][i] = voC[h][i]; }
            PG8_LDB(B0, 0, 0); PG8_LDB(B1, 0, 1); PG8_SCHED; PG8_LDA(At, 0, 0); PG8_STAGE(PG8_SA(1, 1), a1, voC[1]);
            PG8_WAIT_V(8); PG8_WAIT_L(0); PG8_BAR; PG8_MMA(0, 0, At, B0); PG8_MMA(0, 1, At, B1); PG8_BAR; PG8_SCHED;
            PG8_LDA(At, 0, 1); PG8_STAGE(PG8_SB(0, 0), b2, voffB); PG8_STAGE(PG8_SB(0, 1), b2 + hstepB, voffB); PG8_STAGE(PG8_SA(0, 0), a2, v2[0]);
            PG8_WAIT_V(8); PG8_WAIT_L(0); PG8_BAR; PG8_MMA(1, 0, At, B0); PG8_MMA(1, 1, At, B1); PG8_BAR; PG8_SCHED;
            PG8_LDB(B0, 1, 0); PG8_LDB(B1, 1, 1); PG8_SCHED; PG8_LDA(At, 1, 0); PG8_STAGE(PG8_SA(0, 1), a2, v2[1]);
            PG8_WAIT_V(8); PG8_WAIT_L(0); PG8_BAR; PG8_MMA(0, 0, At, B0); PG8_MMA(0, 1, At, B1); PG8_BAR; PG8_SCHED;
            PG8_LDA(At, 1, 1); PG8_STAGE(PG8_SB(1, 0), b3, voffB); PG8_STAGE(PG8_SB(1, 1), b3 + hstepB, voffB); PG8_STAGE(PG8_SA(1, 0), a3, v2[0]);
            PG8_WAIT_V(8); PG8_WAIT_L(0); PG8_BAR; PG8_MMA(1, 0, At, B0); PG8_MMA(1, 1, At, B1); PG8_BAR; PG8_SCHED;
        }
        if (wr == 0) PG8_BAR;
        E(acc, cur, wr, wc, fr, fq);
        if (!has_next) break;
#pragma unroll
        for (int a = 0; a < 2; ++a)
#pragma unroll
            for (int b = 0; b < 2; ++b)
#pragma unroll
                for (int m = 0; m < 4; ++m)
#pragma unroll
                    for (int n = 0; n < 2; ++n) acc[a][b][m][n] = (f32x4){0.f, 0.f, 0.f, 0.f};
        cur = nxt; cA = nA; ++ui;
#pragma unroll
        for (int h = 0; h < 2; ++h)
#pragma unroll
            for (int i = 0; i < 2; ++i) { if constexpr (Prob::GATHER) voC[h][i] = voN[h][i]; }
        if (wr == 1) PG8_BAR;
    }
    PG8_WAIT_V(0);
    PG8_BAR;
#undef PG8_SA
#undef PG8_SB
#undef PG8_STAGE
#undef PG8_LDA
#undef PG8_LDB
#undef PG8_MMA
#undef PG8_WAIT_V
#undef PG8_WAIT_L
#undef PG8_BAR
#undef PG8_SCHED
}
}
using pg8::Unit;

typedef GAS unsigned gu32;
#define XB_TMO      128
#define XB_XCNT(j)  (256  + 64 * (j))
#define XB_XSUB(j)  (1280 + 64 * (j))
#define XB_XGEN(j)  (2304 + 64 * (j))
#define XB_TOP      3328
#define XB_TOPGEN   3392
#define XCD_BAR_WORDS 3456
#define XB_SPIN_CAP (1u << 18)
__device__ __forceinline__ unsigned xb_ld(unsigned* p)              { return __hip_atomic_load(p, __ATOMIC_RELAXED, __HIP_MEMORY_SCOPE_AGENT); }
__device__ __forceinline__ unsigned xb_add(unsigned* p, unsigned v) { return __hip_atomic_fetch_add(p, v, __ATOMIC_RELAXED, __HIP_MEMORY_SCOPE_AGENT); }
__device__ __forceinline__ unsigned xb_xcc_id() { return (unsigned)__builtin_amdgcn_s_getreg((3 << 11) | 20) & 0xFu; }
#define XB_SPIN(cond, bar) do { unsigned _sp = 0; while (cond) { __builtin_amdgcn_s_sleep(1); \
    if ((++_sp & 255u) == 0u) { if (xb_ld(&(bar)[XB_TMO])) break; if (_sp > XB_SPIN_CAP) { atomicAdd(&(bar)[XB_TMO], 1u); break; } } } } while (0)
struct XcdBarrier { unsigned* bar; unsigned x; volatile LAS unsigned* st; };
__device__ __forceinline__ XcdBarrier xcd_barrier_post(unsigned* bar, volatile LAS unsigned* st) {
    XcdBarrier b; b.bar = bar; b.x = xb_xcc_id(); b.st = st;
    if (threadIdx.x == 0) (void)xb_add(&bar[XB_XCNT(b.x)], 1u);
    return b;
}
__device__ __forceinline__ void xcd_barrier_complete(unsigned* bar, unsigned x, unsigned& nloc, unsigned& nx) {
    const unsigned G = gridDim.x * gridDim.y * gridDim.z;
    unsigned sum, cnt, mine, sp = 0u;
    for (;;) {
        sum = 0u; cnt = 0u; mine = 0u;
#pragma unroll
        for (unsigned j = 0; j < 16; ++j) { const unsigned c = xb_ld(&bar[XB_XCNT(j)]); sum += c; cnt += (c > 0u) ? 1u : 0u; mine = (j == x) ? c : mine; }
        if (sum == G) break;
        __builtin_amdgcn_s_sleep(1);
        if ((++sp & 255u) == 0u) { if (xb_ld(&bar[XB_TMO])) break; if (sp > XB_SPIN_CAP) { atomicAdd(&bar[XB_TMO], 1u); break; } }
    }
    nloc = mine > 0u ? mine : 1u; nx = cnt > 0u ? cnt : 1u;
}
__device__ __forceinline__ void xcd_barrier(const XcdBarrier& b) {
    asm volatile("s_waitcnt vmcnt(0)" ::: "memory");
    __syncthreads();
    if (threadIdx.x == 0) {
        unsigned* bar = b.bar;
        __builtin_amdgcn_s_waitcnt(0);
        unsigned nloc = b.st[0], nx = b.st[1];
        if (nloc == 0u) { xcd_barrier_complete(bar, b.x, nloc, nx); b.st[0] = nloc; b.st[1] = nx; }
        const unsigned old = xb_add(&bar[XB_XSUB(b.x)], 1u);
        const unsigned gen = old / nloc;
        if (old + 1u == (gen + 1u) * nloc) {
            __builtin_amdgcn_fence(__ATOMIC_RELEASE, "agent");
            asm volatile("s_waitcnt vmcnt(0)" ::: "memory");
            const unsigned og = xb_add(&bar[XB_TOP], 1u);
            const unsigned tg = og / nx;
            if (og + 1u == (tg + 1u) * nx) xb_add(&bar[XB_TOPGEN], 1u);
            else XB_SPIN(xb_ld(&bar[XB_TOPGEN]) == tg, bar);
            __builtin_amdgcn_fence(__ATOMIC_ACQUIRE, "agent");
            xb_add(&bar[XB_XGEN(b.x)], 1u);
            asm volatile("s_waitcnt vmcnt(0)" ::: "memory");
        } else {
            XB_SPIN(xb_ld(&bar[XB_XGEN(b.x)]) == gen, bar);
            __builtin_amdgcn_fence(__ATOMIC_ACQUIRE, "agent");
            asm volatile("s_waitcnt vmcnt(0)" ::: "memory");
        }
    }
    __syncthreads();
}

struct Frame {
    LAS unsigned char* lds;
    volatile LAS unsigned* MISC;
    unsigned* ctl;
    int tid, lane, wave, vcu, G;
    const float *x, *meta, *g1, *win, *wpool, *pscale, *qg, *kg, *sinks, *wout, *g2, *wgr, *wer, *wgate, *wup, *wdown;
    float* out;
    bf16_t *Win_t, *Wout_t, *Wgu_t, *Wd_t, *Wr_t, *XB, *UB, *QB, *KB, *VB, *YMIX, *H1, *HID;
    float *rope, *rstd1, *rstd2, *wlo, *whi, *ss2;
    int* list;
};

__device__ __forceinline__ void transpose_item(const float* W, int ldw, int k0, int n0, const float* scale, bf16_t* dst, int ldd, LAS float* scr, int lane) {
    const int c4 = lane & 7, kr = lane >> 3;
    f32x4 v[8];
#pragma unroll
    for (int i = 0; i < 8; ++i) v[i] = *(const f32x4*)(W + (size_t)(k0 + 8 * i + kr) * ldw + n0 + 4 * c4);
#pragma unroll
    for (int i = 0; i < 8; ++i) { const int kk = 8 * i + kr; f32x4 t = v[i]; if (scale) t = t * scale[k0 + kk];
        LAS float* d = scr + kk * 33 + 4 * c4; d[0] = t[0]; d[1] = t[1]; d[2] = t[2]; d[3] = t[3]; }
    LDS_WAIT(); asm volatile("" ::: "memory");
    const int c = lane & 7;
#pragma unroll
    for (int j = 0; j < 4; ++j) { const int n = (lane >> 3) + 8 * j; const LAS float* s = scr + (8 * c) * 33 + n;
        u32x4 o; o.x = pk2(s[0 * 33], s[1 * 33]); o.y = pk2(s[2 * 33], s[3 * 33]); o.z = pk2(s[4 * 33], s[5 * 33]); o.w = pk2(s[6 * 33], s[7 * 33]);
        *(u32x4*)(dst + (size_t)n * ldd + 8 * c) = o; }
    LDS_WAIT(); asm volatile("" ::: "memory");
}
__device__ __forceinline__ void row_to_bf16(const float* xrow, bf16_t* orow, float* rstd_out, int lane) {
    const f32x4* xr = (const f32x4*)xrow + lane;
    f32x4 v[4]; float s = 0.f;
#pragma unroll
    for (int j = 0; j < 4; ++j) { v[j] = xr[64 * j]; s += (v[j].x * v[j].x + v[j].y * v[j].y) + (v[j].z * v[j].z + v[j].w * v[j].w); }
    s = wave_sum(s);
    u32x2* o8 = (u32x2*)orow + lane;
#pragma unroll
    for (int j = 0; j < 4; ++j) { u32x2 w; w.x = pk2(v[j].x, v[j].y); w.y = pk2(v[j].z, v[j].w); o8[64 * j] = w; }
    if (lane == 0) *rstd_out = 1.0f / sqrtf(s * (1.0f / DM) + EPS);
}

__device__ __forceinline__ void late_weights(Frame& F, int gw, int NGW) {
    LAS float* scr = (LAS float*)(F.lds + F.wave * 16384);
    const int lane = F.lane;
    constexpr int I_GU = 32 * 128, I_D = 16 * 128, I_O = 8 * 32;
    constexpr int NITEMS = I_GU + I_D + I_O;
    for (int it = gw; it < NITEMS; it += NGW) {
        int r = it;
        if (r < I_GU) { const int mat = r / 128, rr = r % 128, kb = rr / 8, fg = rr % 8, e = mat >> 1, isup = mat & 1;
            const float* W = (isup ? F.wup : F.wgate) + (size_t)e * DM * DEXP;
            const int drow = 256 * (fg >> 2) + 128 * isup + 32 * (fg & 3);
            transpose_item(W, DEXP, kb * 64, fg * 32, F.g2, F.Wgu_t + ((size_t)e * 512 + drow) * DM + kb * 64, DM, scr, lane); continue; }
        r -= I_GU;
        if (r < I_D) { const int e = r / 128, rr = r % 128, kb = rr / 32, nb = rr % 32;
            transpose_item(F.wdown + (size_t)e * DEXP * DM, DM, kb * 64, nb * 32, nullptr, F.Wd_t + ((size_t)e * DM + nb * 32) * DEXP + kb * 64, DEXP, scr, lane); continue; }
        r -= I_D;
        { const int kb = r / 32, nb = r % 32;
            transpose_item(F.wout + (size_t)512 * DM, DM, kb * 64, nb * 32, nullptr, F.Wout_t + (size_t)(nb * 32) * DM + 512 + kb * 64, DM, scr, lane); }
    }
    for (int it = gw; it < 1024; it += NGW) {
        const int g = it >> 8, cc = (it >> 4) & 15, nb = it & 15, n = nb * 64 + lane;
        float a[8];
#pragma unroll
        for (int j = 0; j < 8; ++j) a[j] = 0.f;
        const float* wp = F.wpool + ((size_t)g * 128 + cc * 8) * 128;
#pragma unroll 4
        for (int d = 0; d < 128; ++d) {
            const float wo = F.wout[(size_t)(g * 128 + d) * DM + n] * F.pscale[g * 128 + d];
#pragma unroll
            for (int j = 0; j < 8; ++j) a[j] += wp[j * 128 + d] * wo;
        }
        u32x4 o; o.x = pk2(a[0], a[1]); o.y = pk2(a[2], a[3]); o.z = pk2(a[4], a[5]); o.w = pk2(a[6], a[7]);
        *(u32x4*)(F.Wout_t + (size_t)n * DM + g * 128 + cc * 8) = o;
    }
    for (int i = gw * 64 + lane; i < 32 * DM; i += NGW * 64) {
        const int j = i >> 10, k = i & 1023; float v = 0.f;
        if (j < 16) v = F.wer[k * 16 + j] * F.g2[k]; else if (j < 20) v = F.wgr[k * 4 + (j - 16)] * F.g2[k];
        F.Wr_t[i] = (bf16_t)f2bf(v);
    }
}
__device__ __forceinline__ void p0_prologue(Frame& F) {
    LAS float* scr = (LAS float*)(F.lds + F.wave * 16384);
    const int gw = F.vcu * 8 + F.wave, NGW = F.G * 8, lane = F.lane;
    for (int r = gw; r < 16 * 40; r += NGW) {
        const int kb = r / 40, sg = r % 40; int drow;
        if (sg < 16) drow = sg * 32;
        else if (sg < 32) { const int qc = (sg - 16) * 32, head = qc >> 6, half = (qc >> 5) & 1; drow = 256 * (2 + (head >> 2)) + 128 * half + 32 * (head & 3); }
        else { const int kc = (sg - 32) * 32, hh = kc >> 6, half = (kc >> 5) & 1; drow = 1024 + 128 * half + 32 * hh; }
        transpose_item(F.win, INW, kb * 64, sg * 32, F.g1, F.Win_t + (size_t)drow * DM + kb * 64, DM, scr, lane);
    }
    for (int i = gw * 64 + lane; i < LSEQ * 8; i += NGW * 64) {
        const int pos = i >> 3, fi = i & 7;
        double f = 1.0;
        if (fi == 1) f = 0.19392274474868576; if (fi == 2) f = 0.03760603093086393; if (fi == 3) f = 0.007292664737217109; if (fi == 4) f = 0.001414213562373095;
        if (fi == 5) f = 0.0002742481756762073; if (fi == 6) f = 5.318295896944988e-05; if (fi == 7) f = 1.031338537721246e-05;
        const double rev = (double)pos * f * 0.15915494309189535;
        const double fr = rev - __builtin_floor(rev + 0.5);
        const double qd = __builtin_floor(fr * 4.0 + 0.5);
        const double tt = (fr - qd * 0.25) * 6.283185307179586;
        const double t2 = tt * tt;
        const double sn = tt * (1.0 + t2 * (-1.0 / 6 + t2 * (1.0 / 120 + t2 * (-1.0 / 5040 + t2 * (1.0 / 362880 + t2 * (-1.0 / 39916800 + t2 * (1.0 / 6227020800.0)))))));
        const double cs = 1.0 + t2 * (-0.5 + t2 * (1.0 / 24 + t2 * (-1.0 / 720 + t2 * (1.0 / 40320 + t2 * (-1.0 / 3628800 + t2 * (1.0 / 479001600.0))))));
        const int qi = ((int)qd) & 3;
        const double c4 = (qi == 0) ? cs : (qi == 1) ? -sn : (qi == 2) ? -cs : sn;
        const double s4 = (qi == 0) ? sn : (qi == 1) ? cs : (qi == 2) ? -sn : -cs;
        F.rope[2 * i] = (float)c4; F.rope[2 * i + 1] = (float)s4;
    }
    for (int m = gw; m < T; m += 2 * NGW) {
        const int m2 = m + NGW;
        const f32x4* xa = (const f32x4*)(F.x + (size_t)m * DM) + lane; const f32x4* xb = (const f32x4*)(F.x + (size_t)(m2 < T ? m2 : m) * DM) + lane;
        f32x4 va[4], vb[4]; float sa = 0.f, sb = 0.f;
#pragma unroll
        for (int j = 0; j < 4; ++j) { va[j] = xa[64 * j]; vb[j] = xb[64 * j]; }
#pragma unroll
        for (int j = 0; j < 4; ++j) { sa += (va[j].x * va[j].x + va[j].y * va[j].y) + (va[j].z * va[j].z + va[j].w * va[j].w); sb += (vb[j].x * vb[j].x + vb[j].y * vb[j].y) + (vb[j].z * vb[j].z + vb[j].w * vb[j].w); }
        sa = wave_sum(sa); sb = wave_sum(sb);
        u32x2* oa = (u32x2*)(F.XB + (size_t)m * DM) + lane; u32x2* ob = (u32x2*)(F.XB + (size_t)m2 * DM) + lane;
#pragma unroll
        for (int j = 0; j < 4; ++j) { u32x2 w; w.x = pk2(va[j].x, va[j].y); w.y = pk2(va[j].z, va[j].w); oa[64 * j] = w; }
        if (lane == 0) F.rstd1[m] = 1.0f / sqrtf(sa * (1.0f / DM) + EPS);
        if (m2 < T) {
#pragma unroll
            for (int j = 0; j < 4; ++j) { u32x2 w; w.x = pk2(vb[j].x, vb[j].y); w.y = pk2(vb[j].z, vb[j].w); ob[64 * j] = w; }
            if (lane == 0) F.rstd1[m2] = 1.0f / sqrtf(sb * (1.0f / DM) + EPS);
        }
    }
    for (int m = T + gw; m < T + NMETA; m += NGW) row_to_bf16(F.meta + (size_t)(m - T) * DM, F.XB + (size_t)m * DM, F.rstd1 + m, lane);
    for (int i = gw * 64 + lane; i < (256 - NMETA) * DM / 8; i += NGW * 64) ((u32x4*)(F.XB + (size_t)(T + NMETA) * DM))[i] = (u32x4){0u, 0u, 0u, 0u};
    for (int i = gw * 64 + lane; i < 256 - NMETA; i += NGW * 64) F.rstd1[T + NMETA + i] = 0.f;
    for (int i = gw * 64 + lane; i < 32 * 16 * 8; i += NGW * 64) { const int bh = i >> 7, r = (i >> 3) & 15, c = i & 7;
        *(u32x4*)(F.KB + ((size_t)bh * LP + LSEQ + r) * HD + c * 8) = (u32x4){0u, 0u, 0u, 0u}; }
    for (int i = gw * 64 + lane; i < 32 * 64 * 2; i += NGW * 64) { const int row = i >> 1, c = i & 1;
        *(u32x4*)(F.VB + (size_t)row * LP + LSEQ + c * 8) = (u32x4){0u, 0u, 0u, 0u}; }
}

struct SchedP1 { int G, c;
    __device__ __forceinline__ bool next(int i, Unit& u) const { const int L = i * G + c; if (L >= 643) return false;
        if (L < 640) { u.pm = L / 5; u.pn = L % 5; } else { u.pm = 128; u.pn = (L == 642) ? 4 : (L - 640); }
        u.ui = 0; u.x0 = 0; u.x1 = 0; u.nv = 256; return true; } };
struct SchedP3 { int G, c;
    __device__ __forceinline__ bool next(int i, Unit& u) const { const int L = i * G + c; if (L >= 512) return false; u.pm = L >> 2; u.pn = L & 3; u.ui = 0; u.x0 = 0; u.x1 = 0; u.nv = 256; return true; } };
struct SchedMoe { const LAS int* hdr;
    __device__ __forceinline__ bool next(int i, Unit& u) const {
        const int n = __builtin_amdgcn_readfirstlane(hdr[MAXU * 8]); if (i >= n) return false;
        u.pm = __builtin_amdgcn_readfirstlane(hdr[i * 8 + 0]); u.pn = __builtin_amdgcn_readfirstlane(hdr[i * 8 + 1]);
        u.x0 = __builtin_amdgcn_readfirstlane(hdr[i * 8 + 2]); u.x1 = __builtin_amdgcn_readfirstlane(hdr[i * 8 + 3]);
        u.nv = __builtin_amdgcn_readfirstlane(hdr[i * 8 + 4]); u.ui = i; return true; } };

struct ProbLinear { static constexpr bool GATHER = false; const bf16_t* A; const bf16_t* Bt; int K, lda, ldb;
    __device__ __forceinline__ const char* a_base(const Unit& u) const { return (const char*)A + (size_t)u.pm * 256 * lda * 2; }
    __device__ __forceinline__ void a_voff(const Unit&, const int (&Rp)[2], const int (&Cp)[2], unsigned (&vo)[2][2]) const {
#pragma unroll
        for (int h = 0; h < 2; ++h)
#pragma unroll
            for (int i = 0; i < 2; ++i) vo[h][i] = (unsigned)((h * 128 + Rp[i]) * lda + Cp[i]) * 2u; }
    __device__ __forceinline__ const char* b_tile(const Unit& u, int kt) const { return (const char*)Bt + (size_t)u.pn * 256 * ldb * 2 + (size_t)kt * 128; } };
struct ProbG1 { static constexpr bool GATHER = true; const bf16_t* A; const bf16_t* Wgu; const LAS int* tokT; int K, lda, ldb;
    __device__ __forceinline__ const char* a_base(const Unit&) const { return (const char*)A; }
    __device__ __forceinline__ void a_voff(const Unit& u, const int (&Rp)[2], const int (&Cp)[2], unsigned (&vo)[2][2]) const {
#pragma unroll
        for (int h = 0; h < 2; ++h)
#pragma unroll
            for (int i = 0; i < 2; ++i) { const int tok = tokT[u.ui * 256 + h * 128 + Rp[i]]; vo[h][i] = (unsigned)(tok * DM + Cp[i]) * 2u; } }
    __device__ __forceinline__ const char* b_tile(const Unit& u, int kt) const { const int e = (u.pn < 2) ? u.x0 : u.x1;
        return (const char*)Wgu + ((size_t)e * 512 + (u.pn & 1) * 256) * DM * 2 + (size_t)kt * 128; } };
struct ProbG2 { static constexpr bool GATHER = false; const bf16_t* A; const bf16_t* Wd; int K, lda, ldb;
    __device__ __forceinline__ const char* a_base(const Unit& u) const { return (const char*)A + (size_t)u.pm * 256 * 512 * 2; }
    __device__ __forceinline__ void a_voff(const Unit&, const int (&Rp)[2], const int (&Cp)[2], unsigned (&vo)[2][2]) const {
#pragma unroll
        for (int h = 0; h < 2; ++h)
#pragma unroll
            for (int i = 0; i < 2; ++i) vo[h][i] = (unsigned)((h * 128 + Rp[i]) * 512 + Cp[i]) * 2u; }
    __device__ __forceinline__ const char* b_tile(const Unit& u, int kt) const { const int e = (kt < 4) ? u.x0 : u.x1;
        return (const char*)Wd + ((size_t)e * DM + u.pn * 256) * DEXP * 2 + (size_t)(kt & 3) * 128; } };

struct EpiP1 { static constexpr bool PERM = true;
    const float* rstd1; const float* rope; const float* qg; const float* kg; bf16_t *UB, *QB, *KB, *VB;
    __device__ __forceinline__ void operator()(const f32x4 (&acc)[2][2][4][2], const Unit& u, int wr, int wc, int fr, int fq) const {
        asm volatile("" : "+v"(fr), "+v"(fq));
        const bool meta = (u.pm == 128);
#pragma unroll
        for (int ai = 0; ai < 2; ++ai)
#pragma unroll
            for (int m = 0; m < 4; ++m) {
                const int rl = ai * 128 + wr * 64 + m * 16 + fr, grow = u.pm * 256 + rl;
                const float rs = rstd1[grow];
                const bool valid = !meta || rl < NMETA;
                const int b = grow >> 11, pos = meta ? rl : (grow & 2047) + NMETA;
                f32x4 v[2][2];
#pragma unroll
                for (int bj = 0; bj < 2; ++bj)
#pragma unroll
                    for (int n = 0; n < 2; ++n) v[bj][n] = acc[ai][bj][m][n] * rs;
                if (u.pn < 2) {
#pragma unroll
                    for (int bj = 0; bj < 2; ++bj) { u32x4 w; w.x = pg8::cvt_pk_bf16(v[bj][0][0], v[bj][0][1]); w.y = pg8::cvt_pk_bf16(v[bj][0][2], v[bj][0][3]); w.z = pg8::cvt_pk_bf16(v[bj][1][0], v[bj][1][1]); w.w = pg8::cvt_pk_bf16(v[bj][1][2], v[bj][1][3]);
                        const int col = u.pn * 256 + bj * 128 + wc * 32 + fq * 8;
                        if (!meta) *(u32x4*)(UB + ((size_t)b * LSEQ + pos) * 512 + col) = w;
                        else if (valid) { for (int bb = 0; bb < NB; ++bb) *(u32x4*)(UB + ((size_t)bb * LSEQ + pos) * 512 + col) = w; } }
                } else {
                    const bool isv = (u.pn == 4) && (wc >= 2);
                    if (!isv) {
                        float ss = 0.f;
#pragma unroll
                        for (int bj = 0; bj < 2; ++bj)
#pragma unroll
                            for (int n = 0; n < 2; ++n) ss += (v[bj][n][0] * v[bj][n][0] + v[bj][n][1] * v[bj][n][1]) + (v[bj][n][2] * v[bj][n][2] + v[bj][n][3] * v[bj][n][3]);
                        ss += __shfl_xor(ss, 16); ss += __shfl_xor(ss, 32);
                        const float rn = 1.0f / sqrtf(ss * (1.0f / HD) + EPS);
                        const float* gp = (u.pn == 4) ? kg : qg;
#pragma unroll
                        for (int bj = 0; bj < 2; ++bj)
#pragma unroll
                            for (int n = 0; n < 2; ++n) { const f32x4 gv = *(const f32x4*)(gp + 32 * bj + 8 * fq + 4 * n); v[bj][n] = v[bj][n] * rn * gv; }
#pragma unroll
                        for (int n = 0; n < 2; ++n) {
                            const f32x4 cs0 = *(const f32x4*)(rope + ((size_t)pos * 8 + 4 * n) * 2), cs1 = *(const f32x4*)(rope + ((size_t)pos * 8 + 4 * n) * 2 + 4);
                            const float c[4] = {cs0[0], cs0[2], cs1[0], cs1[2]}, s[4] = {cs0[1], cs0[3], cs1[1], cs1[3]};
#pragma unroll
                            for (int jj = 0; jj < 4; ++jj) { const float mine = v[0][n][jj], oth = __shfl_xor(mine, 16);
                                const float r = (fq == 0) ? (mine * c[jj] - oth * s[jj]) : (mine * c[jj] + oth * s[jj]);
                                v[0][n][jj] = (fq < 2) ? r : mine; }
                        }
                        if (u.pn != 4) {
#pragma unroll
                            for (int bj = 0; bj < 2; ++bj)
#pragma unroll
                                for (int n = 0; n < 2; ++n) v[bj][n] = v[bj][n] * QSCALE;
                        }
                    }
                    if (isv) {
                        const int pp = (pos & ~15) | (((pos >> 2) & 1) << 3) | (((pos >> 3) & 1) << 2) | (pos & 3); const int hh = wc & 1;
#pragma unroll
                        for (int bj = 0; bj < 2; ++bj)
#pragma unroll
                            for (int n = 0; n < 2; ++n)
#pragma unroll
                                for (int jj = 0; jj < 4; ++jj) { const int d = 32 * bj + 8 * fq + 4 * n + jj; const bf16_t hv = (bf16_t)f2bf(v[bj][n][jj]);
                                    if (!meta) VB[(((size_t)b * 2 + hh) * HD + d) * LP + pp] = hv;
                                    else if (valid) { for (int bb = 0; bb < NB; ++bb) VB[(((size_t)bb * 2 + hh) * HD + d) * LP + pp] = hv; } }
                    } else {
#pragma unroll
                    for (int bj = 0; bj < 2; ++bj) { u32x4 w; w.x = pg8::cvt_pk_bf16(v[bj][0][0], v[bj][0][1]); w.y = pg8::cvt_pk_bf16(v[bj][0][2], v[bj][0][3]); w.z = pg8::cvt_pk_bf16(v[bj][1][0], v[bj][1][1]); w.w = pg8::cvt_pk_bf16(v[bj][1][2], v[bj][1][3]);
                        const int d0 = 32 * bj + 8 * fq;
                        if (u.pn != 4) { const int head = 4 * (u.pn - 2) + wc; *(u32x4*)(QB + (size_t)grow * 512 + head * HD + d0) = w; }
                        else { const int hh = wc & 1;
                            if (!meta) *(u32x4*)(KB + (((size_t)b * 2 + hh) * LP + pos) * HD + d0) = w;
                            else if (valid) { for (int bb = 0; bb < NB; ++bb) *(u32x4*)(KB + (((size_t)bb * 2 + hh) * LP + pos) * HD + d0) = w; } } }
                    }
                }
            }
    }
};
struct EpiP3 { static constexpr bool PERM = true;
    const bf16_t* xb; bf16_t* H1; float* ss2;
    __device__ __forceinline__ void operator()(const f32x4 (&acc)[2][2][4][2], const Unit& u, int wr, int wc, int fr, int fq) const {
        asm volatile("" : "+v"(fr), "+v"(fq));
#pragma unroll
        for (int ai = 0; ai < 2; ++ai)
#pragma unroll
            for (int m = 0; m < 4; ++m) {
                const int grow = u.pm * 256 + ai * 128 + wr * 64 + m * 16 + fr; float ss = 0.f;
#pragma unroll
                for (int bj = 0; bj < 2; ++bj) { const size_t off = (size_t)grow * DM + u.pn * 256 + bj * 128 + wc * 32 + fq * 8;
                    const u32x4 xw = *(const u32x4*)(xb + off);
                    f32x4 h0 = acc[ai][bj][m][0], h1 = acc[ai][bj][m][1];
                    h0[0] += bflo(xw.x); h0[1] += bfhi(xw.x); h0[2] += bflo(xw.y); h0[3] += bfhi(xw.y); h1[0] += bflo(xw.z); h1[1] += bfhi(xw.z); h1[2] += bflo(xw.w); h1[3] += bfhi(xw.w);
                    ss += (h0[0] * h0[0] + h0[1] * h0[1]) + (h0[2] * h0[2] + h0[3] * h0[3]) + (h1[0] * h1[0] + h1[1] * h1[1]) + (h1[2] * h1[2] + h1[3] * h1[3]);
                    u32x4 w; w.x = pg8::cvt_pk_bf16(h0[0], h0[1]); w.y = pg8::cvt_pk_bf16(h0[2], h0[3]); w.z = pg8::cvt_pk_bf16(h1[0], h1[1]); w.w = pg8::cvt_pk_bf16(h1[2], h1[3]);
                    *(u32x4*)(H1 + off) = w; }
                ss += __shfl_xor(ss, 16); ss += __shfl_xor(ss, 32);
                if (fq == 0) ss2[(size_t)(u.pn * 4 + wc) * T + grow] = ss;
            }
    }
};
struct EpiG1 { static constexpr bool PERM = true;
    bf16_t* HID; const LAS float* rstdT; const LAS float* wloT; const LAS float* whiT;
    __device__ __forceinline__ void operator()(const f32x4 (&acc)[2][2][4][2], const Unit& u, int wr, int wc, int fr, int fq) const {
        asm volatile("" : "+v"(fr), "+v"(fq));
        const LAS float* wT = (u.pn < 2) ? wloT : whiT;
#pragma unroll
        for (int ai = 0; ai < 2; ++ai)
#pragma unroll
            for (int m = 0; m < 4; ++m) {
                const int rl = ai * 128 + wr * 64 + m * 16 + fr; const float rs = rstdT[u.ui * 256 + rl], w = wT[u.ui * 256 + rl];
                float h[8];
#pragma unroll
                for (int n = 0; n < 2; ++n)
#pragma unroll
                    for (int jj = 0; jj < 4; ++jj) { const float g = acc[ai][0][m][n][jj] * rs, up = acc[ai][1][m][n][jj] * rs;
                        h[n * 4 + jj] = g / (1.0f + __expf(-g)) * up * w; }
                u32x4 o; o.x = pg8::cvt_pk_bf16(h[0], h[1]); o.y = pg8::cvt_pk_bf16(h[2], h[3]); o.z = pg8::cvt_pk_bf16(h[4], h[5]); o.w = pg8::cvt_pk_bf16(h[6], h[7]);
                *(u32x4*)(HID + ((size_t)u.pm * 256 + rl) * 512 + u.pn * 128 + wc * 32 + fq * 8) = o;
            }
    }
};
struct EpiG2 { static constexpr bool PERM = false;
    float* out; const bf16_t* H1; const LAS int* tokT;
    __device__ __forceinline__ void operator()(const f32x4 (&acc)[2][2][4][2], const Unit& u, int wr, int wc, int fr, int fq) const {
        asm volatile("" : "+v"(fr), "+v"(fq));
#pragma unroll
        for (int ai = 0; ai < 2; ++ai)
#pragma unroll
            for (int m = 0; m < 4; ++m) {
                const int rl = ai * 128 + wr * 64 + m * 16 + fr; const int tok = tokT[u.ui * 256 + rl];
                if (rl < u.nv) {
#pragma unroll
                    for (int bj = 0; bj < 2; ++bj)
#pragma unroll
                        for (int n = 0; n < 2; ++n) { const size_t off = (size_t)tok * DM + u.pn * 256 + bj * 128 + wc * 32 + n * 16 + fq * 4;
                            const u32x2 hb = *(const u32x2*)(H1 + off);
                            f32x4 o = acc[ai][bj][m][n]; o[0] += bflo(hb.x); o[1] += bfhi(hb.x); o[2] += bflo(hb.y); o[3] += bfhi(hb.y);
                            *(f32x4*)(out + off) = o; }
                }
            }
    }
};

__device__ __forceinline__ void p2_pool(Frame& F) {
    const int gw = F.vcu * 8 + F.wave, NGW = F.G * 8, lane = F.lane;
    const int g = lane >> 4, w = 2 << g; const float invw = 1.0f / (float)w;
    for (int task = gw; task < T / 16; task += NGW) {
        const int m0 = task * 16, b = m0 >> 11, pos0 = (m0 & 2047) + NMETA;
        const bf16_t* up = F.UB + ((size_t)b * LSEQ + pos0) * 512 + lane * 8;
        float a[8];
#pragma unroll
        for (int j = 0; j < 8; ++j) a[j] = 0.f;
        for (int i = 1; i < w; ++i) { const u32x4 q = *(const u32x4*)(up - (size_t)i * 512);
            a[0] += bflo(q.x); a[1] += bfhi(q.x); a[2] += bflo(q.y); a[3] += bfhi(q.y); a[4] += bflo(q.z); a[5] += bfhi(q.z); a[6] += bflo(q.w); a[7] += bfhi(q.w); }
#pragma unroll 4
        for (int t = 0; t < 16; ++t) {
            const u32x4 nw = *(const u32x4*)(up + (size_t)t * 512);
            a[0] += bflo(nw.x); a[1] += bfhi(nw.x); a[2] += bflo(nw.y); a[3] += bfhi(nw.y); a[4] += bflo(nw.z); a[5] += bfhi(nw.z); a[6] += bflo(nw.w); a[7] += bfhi(nw.w);
            u32x4 o;
            o.x = pk2(a[0] * invw - bflo(nw.x), a[1] * invw - bfhi(nw.x)); o.y = pk2(a[2] * invw - bflo(nw.y), a[3] * invw - bfhi(nw.y));
            o.z = pk2(a[4] * invw - bflo(nw.z), a[5] * invw - bfhi(nw.z)); o.w = pk2(a[6] * invw - bflo(nw.w), a[7] * invw - bfhi(nw.w));
            *(u32x4*)(F.YMIX + (size_t)(m0 + t) * DM + lane * 8) = o;
            const u32x4 od = *(const u32x4*)(up + (long)(t - (w - 1)) * 512);
            a[0] -= bflo(od.x); a[1] -= bfhi(od.x); a[2] -= bflo(od.y); a[3] -= bfhi(od.y); a[4] -= bflo(od.z); a[5] -= bfhi(od.z); a[6] -= bflo(od.w); a[7] -= bfhi(od.w);
        }
    }
}
typedef float f32x16 __attribute__((ext_vector_type(16)));
template <int MODE>
__device__ __forceinline__ void attn_tile(f32x16& o0, f32x16& o1, float& l, const bf16x8 (&qf)[4], const bf16_t* kr, const bf16_t* vr, float cinit, int x, int thr, bool ex) {
    f32x16 s;
#pragma unroll
    for (int r = 0; r < 16; ++r) s[r] = cinit;
#pragma unroll
    for (int ks = 0; ks < 4; ++ks) { const bf16x8 kf = *(const bf16x8*)(kr + 16 * ks); s = __builtin_amdgcn_mfma_f32_32x32x16_bf16(kf, qf[ks], s, 0, 0, 0); }
    float e[16];
#pragma unroll
    for (int r = 0; r < 16; ++r) {
        const int c = (r & 3) + 8 * (r >> 2);
        float v = __builtin_amdgcn_exp2f(s[r]);
        if (MODE == 1) { bool vis = (x - c) < thr; if (r < 8) vis = vis || ex; v = vis ? v : 0.f; }
        if (MODE == 2) { const bool vis = (x - c) >= thr; v = vis ? v : 0.f; }
        if (MODE == 3) { if (r >= 8) v = 0.f; }
        e[r] = v; l += v;
    }
    bf16x8 pf0, pf1;
    { u32x4 w0, w1;
      w0.x = pg8::cvt_pk_bf16(e[0], e[1]); w0.y = pg8::cvt_pk_bf16(e[2], e[3]); w0.z = pg8::cvt_pk_bf16(e[4], e[5]); w0.w = pg8::cvt_pk_bf16(e[6], e[7]);
      w1.x = pg8::cvt_pk_bf16(e[8], e[9]); w1.y = pg8::cvt_pk_bf16(e[10], e[11]); w1.z = pg8::cvt_pk_bf16(e[12], e[13]); w1.w = pg8::cvt_pk_bf16(e[14], e[15]);
      pf0 = __builtin_bit_cast(bf16x8, w0); pf1 = __builtin_bit_cast(bf16x8, w1); }
    { const bf16x8 v00 = *(const bf16x8*)(vr), v10 = *(const bf16x8*)(vr + (size_t)32 * LP);
      o0 = __builtin_amdgcn_mfma_f32_32x32x16_bf16(v00, pf0, o0, 0, 0, 0); o1 = __builtin_amdgcn_mfma_f32_32x32x16_bf16(v10, pf0, o1, 0, 0, 0); }
    if (MODE != 3) { const bf16x8 v01 = *(const bf16x8*)(vr + 16), v11 = *(const bf16x8*)(vr + (size_t)32 * LP + 16);
      o0 = __builtin_amdgcn_mfma_f32_32x32x16_bf16(v01, pf1, o0, 0, 0, 0); o1 = __builtin_amdgcn_mfma_f32_32x32x16_bf16(v11, pf1, o1, 0, 0, 0); }
}
__device__ __forceinline__ void p2_attn(Frame& F) {
    const int lane = F.lane, wave = F.wave, r = lane & 31, h = lane >> 5;
    const float gq = wave_max(fabsf(F.qg[lane])), gk = wave_max(fabsf(F.kg[lane]));
    const float cb = 8.0f * LOG2E * gq * gk * 1.01f;
    const int x = r - 4 * h;
    for (int bt = F.vcu; bt < NB * NKVH * 32; bt += F.G) {
        const int b = bt >> 6, kvh = (bt >> 5) & 1, qt = 2 * (bt & 31) + (wave >> 2), hq = wave & 3, head = kvh * 4 + hq;
        const int m0 = b * SEQ + 32 * qt;
        const bf16_t* qp = F.QB + (size_t)(m0 + r) * 512 + head * HD + 8 * h;
        bf16x8 qf[4];
#pragma unroll
        for (int ks = 0; ks < 4; ++ks) qf[ks] = *(const bf16x8*)(qp + 16 * ks);
        const bf16_t* Kp = F.KB + ((size_t)b * 2 + kvh) * LP * HD + (size_t)r * HD + 8 * h;
        const bf16_t* Vp = F.VB + (((size_t)b * 2 + kvh) * HD + r) * LP + 8 * h;
        f32x16 o0, o1;
#pragma unroll
        for (int i = 0; i < 16; ++i) { o0[i] = 0.f; o1[i] = 0.f; }
        float l = 0.f;
        const float NEG = -1.0e30f;
        attn_tile<3>(o0, o1, l, qf, Kp, Vp, (qt >= 5) ? -cb : NEG, x, 0, false);
        { const int kt = qt - 4, kc = kt < 0 ? 0 : kt; attn_tile<1>(o0, o1, l, qf, Kp + (size_t)kc * 32 * HD, Vp + kc * 32, kt >= 0 ? -cb : NEG, x, -16, kt == 0); }
        { const int kt = qt - 3, kc = kt < 0 ? 0 : kt; attn_tile<1>(o0, o1, l, qf, Kp + (size_t)kc * 32 * HD, Vp + kc * 32, kt >= 0 ? -cb : NEG, x, 16, kt == 0); }
        { const int kt = qt - 2, kc = kt < 0 ? 0 : kt; attn_tile<0>(o0, o1, l, qf, Kp + (size_t)kc * 32 * HD, Vp + kc * 32, kt >= 0 ? -cb : NEG, x, 0, false); }
        { const int kt = qt - 1, kc = kt < 0 ? 0 : kt; attn_tile<0>(o0, o1, l, qf, Kp + (size_t)kc * 32 * HD, Vp + kc * 32, kt >= 0 ? -cb : NEG, x, 0, false); }
        { const int kt = qt;                           attn_tile<2>(o0, o1, l, qf, Kp + (size_t)kt * 32 * HD, Vp + kt * 32, -cb, x, -16, false); }
        { const int kt = qt + 1;                       attn_tile<2>(o0, o1, l, qf, Kp + (size_t)kt * 32 * HD, Vp + kt * 32, -cb, x, 16, false); }
        l += __shfl_xor(l, 32);
        l += __builtin_amdgcn_exp2f(F.sinks[head] * LOG2E - cb);
        const float inv = 1.0f / l;
        bf16_t* op = F.YMIX + (size_t)(m0 + r) * DM + 512 + head * HD + 4 * h;
#pragma unroll
        for (int g4 = 0; g4 < 4; ++g4) {
            u32x2 w0, w1;
            w0.x = pg8::cvt_pk_bf16(o0[4 * g4] * inv, o0[4 * g4 + 1] * inv); w0.y = pg8::cvt_pk_bf16(o0[4 * g4 + 2] * inv, o0[4 * g4 + 3] * inv);
            w1.x = pg8::cvt_pk_bf16(o1[4 * g4] * inv, o1[4 * g4 + 1] * inv); w1.y = pg8::cvt_pk_bf16(o1[4 * g4 + 2] * inv, o1[4 * g4 + 3] * inv);
            *(u32x2*)(op + 8 * g4) = w0; *(u32x2*)(op + 32 + 8 * g4) = w1;
        }
    }
}

__device__ __forceinline__ void p4_route(Frame& F, int dummy) {
    const int lane = F.lane, wave = F.wave, tid = F.tid;
    LAS float* lg = (LAS float*)(F.lds) + wave * 512;
    LAS int* hist = (LAS int*)(F.lds + 32768);
    for (int chunk = F.vcu; chunk < T / 128; chunk += F.G) {
        if (tid < 48) hist[tid] = 0;
        __syncthreads();
        const int tok0 = chunk * 128 + wave * 16;
        f32x4 a0 = {0.f, 0.f, 0.f, 0.f}, a1 = {0.f, 0.f, 0.f, 0.f};
        const bf16_t* hp = F.H1 + (size_t)(tok0 + (lane & 15)) * DM + 8 * (lane >> 4);
        const bf16_t* wp = F.Wr_t + (size_t)(lane & 15) * DM + 8 * (lane >> 4);
#pragma unroll 8
        for (int kk = 0; kk < 32; ++kk) { const bf16x8 a = *(const bf16x8*)(hp + kk * 32), b0 = *(const bf16x8*)(wp + kk * 32), b1 = *(const bf16x8*)(wp + 16 * DM + kk * 32);
            a0 = __builtin_amdgcn_mfma_f32_16x16x32_bf16(a, b0, a0, 0, 0, 0); a1 = __builtin_amdgcn_mfma_f32_16x16x32_bf16(a, b1, a1, 0, 0, 0); }
#pragma unroll
        for (int r = 0; r < 4; ++r) { lg[(4 * (lane >> 4) + r) * 32 + (lane & 15)] = a0[r]; lg[(4 * (lane >> 4) + r) * 32 + 16 + (lane & 15)] = a1[r]; }
        LDS_WAIT(); asm volatile("" ::: "memory");
        int p = 0, rank = 0; float wlo = 0.f, whi = 0.f, rs = 0.f; const int tok = tok0 + lane;
        if (lane < 16) {
            float ss = 0.f;
#pragma unroll
            for (int q = 0; q < 16; ++q) ss += F.ss2[(size_t)q * T + tok];
            rs = 1.0f / sqrtf(ss * (1.0f / DM) + EPS);
            const LAS float* l = lg + lane * 32;
            const float g0 = l[16] * rs, g1 = l[17] * rs, g2 = l[18] * rs, g3 = l[19] * rs;
            int gi = 0; float gm = g0; if (g1 > gm) { gm = g1; gi = 1; } if (g2 > gm) { gm = g2; gi = 2; } if (g3 > gm) { gm = g3; gi = 3; }
            const float gprob = 1.0f / (expf(g0 - gm) + expf(g1 - gm) + expf(g2 - gm) + expf(g3 - gm));
            const float e0 = l[gi * 4 + 0] * rs, e1 = l[gi * 4 + 1] * rs, e2 = l[gi * 4 + 2] * rs, e3 = l[gi * 4 + 3] * rs;
            int i1 = 0; float v1 = e0; if (e1 > v1) { v1 = e1; i1 = 1; } if (e2 > v1) { v1 = e2; i1 = 2; } if (e3 > v1) { v1 = e3; i1 = 3; }
            int i2 = -1; float v2 = -3.0e38f;
            if (i1 != 0 && e0 > v2) { v2 = e0; i2 = 0; } if (i1 != 1 && e1 > v2) { v2 = e1; i2 = 1; } if (i1 != 2 && e2 > v2) { v2 = e2; i2 = 2; } if (i1 != 3 && e3 > v2) { v2 = e3; i2 = 3; }
            const float p1 = 1.0f / (1.0f + expf(v2 - v1)), p2 = 1.0f - p1;
            const float w1 = p1 * gprob, w2 = p2 * gprob;
            const int lo = i1 < i2 ? i1 : i2, hi = i1 < i2 ? i2 : i1;
            wlo = i1 < i2 ? w1 : w2; whi = i1 < i2 ? w2 : w1;
            const int pidx = (lo == 0) ? (hi - 1) : (lo == 1 ? hi + 1 : 5);
            p = gi * 6 + pidx;
            rank = __hip_atomic_fetch_add(&hist[p], 1, __ATOMIC_RELAXED, __HIP_MEMORY_SCOPE_WORKGROUP);
        }
        __syncthreads();
        if (tid < NPAIR) hist[24 + tid] = (int)atomicAdd(F.ctl + CW_CNT + dummy * 32 + tid, (unsigned)hist[tid]);
        __syncthreads();
        if (lane < 16) { const int slot = hist[24 + p] + rank; int* lp = dummy ? (int*)F.HID : F.list; float* r2 = dummy ? (float*)F.HID + 2 * MiB : F.rstd2; float* wl = dummy ? (float*)F.HID + 3 * MiB : F.wlo; float* wh = dummy ? (float*)F.HID + 4 * MiB : F.whi;
            lp[(size_t)p * T + slot] = tok; r2[tok] = rs; wl[tok] = wlo; wh[tok] = whi; }
        __syncthreads();
    }
}
__device__ __forceinline__ void moe_tables(Frame& F) {
    LAS int* tokT = (LAS int*)(F.lds + TAB_TOK); LAS float* rstdT = (LAS float*)(F.lds + TAB_RSTD); LAS float* wloT = (LAS float*)(F.lds + TAB_WLO); LAS float* whiT = (LAS float*)(F.lds + TAB_WHI);
    LAS int* hdr = (LAS int*)(F.lds + TAB_HDR); LAS int* pre = hdr + 64;
    const int tid = F.tid;
    if (tid < NPAIR) pre[32 + tid] = (int)__hip_atomic_load(F.ctl + CW_CNT + tid, __ATOMIC_RELAXED, __HIP_MEMORY_SCOPE_AGENT);
    __syncthreads();
    if (tid == 0) { int s = 0; for (int p = 0; p < NPAIR; ++p) { pre[p] = s; s += (pre[32 + p] + 255) >> 8; } pre[NPAIR] = s; }
    __syncthreads();
    const int NT = pre[NPAIR];
    int nu = 0;
    for (int ui = 0; ui < MAXU; ++ui) {
        const int L = ui * F.G + F.vcu; if (L >= 4 * NT) break;
        const int rt = L >> 2, j = L & 3; int p = 0;
        for (int q = 0; q < NPAIR; ++q) if (pre[q] <= rt && rt < pre[q + 1]) p = q;
        const int t = rt - pre[p], cntp = pre[32 + p]; const int nv = (cntp - 256 * t) < 256 ? (cntp - 256 * t) : 256;
        const int g = p / 6, pi = p % 6; const int lo = (pi < 3) ? 0 : (pi < 5 ? 1 : 2); const int hi = (pi < 3) ? pi + 1 : (pi < 5 ? pi - 1 : 3);
        if (tid == 0) { hdr[ui * 8 + 0] = rt; hdr[ui * 8 + 1] = j; hdr[ui * 8 + 2] = g * 4 + lo; hdr[ui * 8 + 3] = g * 4 + hi; hdr[ui * 8 + 4] = nv; }
        if (tid < 256) { const int r = tid < nv ? tid : 0; const int tok = F.list[(size_t)p * T + 256 * t + r];
            tokT[ui * 256 + tid] = tok; rstdT[ui * 256 + tid] = F.rstd2[tok]; wloT[ui * 256 + tid] = tid < nv ? F.wlo[tok] : 0.f; whiT[ui * 256 + tid] = tid < nv ? F.whi[tok] : 0.f; }
        ++nu;
    }
    if (tid == 0) hdr[MAXU * 8] = nu;
    __syncthreads();
}

struct Args { const float* in[16]; float* out; unsigned char* ws; int ph_lo, ph_hi; int reps[10]; };
constexpr int N_LAUNCHES = MK_N_LAUNCHES;
constexpr int PER_PHASE = 7;

__global__ void __launch_bounds__(512, 2) hymba_fwd(Args args) {
    extern __shared__ __attribute__((aligned(16))) unsigned char lds[];
    Frame F;
    F.lds = (LAS unsigned char*)lds;
    F.MISC = (volatile LAS unsigned*)(F.lds + MISC_OFF);
    F.tid = threadIdx.x; F.lane = F.tid & 63; F.wave = __builtin_amdgcn_readfirstlane(F.tid >> 6);
    F.G = gridDim.x; { const int bx = blockIdx.x; F.vcu = (F.G % 8 == 0) ? (bx % 8) * (F.G / 8) + bx / 8 : bx; }
    unsigned char* ws = args.ws;
    F.ctl = (unsigned*)(ws + WS_CTL);
    F.x = args.in[0]; F.meta = args.in[1]; F.g1 = args.in[2]; F.win = args.in[3]; F.wpool = args.in[4]; F.pscale = args.in[5]; F.qg = args.in[6]; F.kg = args.in[7];
    F.sinks = args.in[8]; F.wout = args.in[9]; F.g2 = args.in[10]; F.wgr = args.in[11]; F.wer = args.in[12]; F.wgate = args.in[13]; F.wup = args.in[14]; F.wdown = args.in[15];
    F.out = args.out;
    F.Win_t = (bf16_t*)(ws + WS_WIN); F.Wout_t = (bf16_t*)(ws + WS_WOUT); F.Wgu_t = (bf16_t*)(ws + WS_WGU); F.Wd_t = (bf16_t*)(ws + WS_WD); F.Wr_t = (bf16_t*)(ws + WS_WR);
    F.XB = (bf16_t*)(ws + WS_XB); F.UB = (bf16_t*)(ws + WS_U); F.QB = (bf16_t*)(ws + WS_Q); F.KB = (bf16_t*)(ws + WS_K); F.VB = (bf16_t*)(ws + WS_V);
    F.YMIX = (bf16_t*)(ws + WS_YMIX); F.H1 = (bf16_t*)(ws + WS_H1); F.HID = (bf16_t*)(ws + WS_HID);
    F.rope = (float*)(ws + WS_ROPE); F.rstd1 = (float*)(ws + WS_RSTD1); F.rstd2 = (float*)(ws + WS_RSTD2); F.wlo = (float*)(ws + WS_WLO); F.whi = (float*)(ws + WS_WHI); F.ss2 = (float*)(ws + WS_SS2);
    F.list = (int*)(ws + WS_LIST);
    for (int u = F.tid; u < (LDS_BYTES - TAB_HDR) / 4; u += 512) ((LAS unsigned*)(F.lds + TAB_HDR))[u] = 0u;
    __syncthreads();
    XcdBarrier bar; bar.bar = (unsigned*)(F.ctl + CW_BAR); bar.x = 0; bar.st = nullptr;
    if (N_LAUNCHES == 1) bar = xcd_barrier_post((unsigned*)(F.ctl + CW_BAR), F.MISC + 8);
    const int lo = args.ph_lo, hi = args.ph_hi;
#ifndef PHASE_MASK
#define PHASE_MASK 0x7f
#endif
#define IN(k) (((PHASE_MASK >> (k)) & 1) && lo <= (k) && (k) < hi)
#define BOTH(k) (IN(k) && IN((k) + 1))
#define GRID_BAR() do { if (N_LAUNCHES == 1) { for (int rb_ = 0; rb_ < args.reps[8]; ++rb_) xcd_barrier(bar); } } while (0)
#ifndef REPEAT_MASK
#define REPEAT_MASK 0
#endif
#define REP(k) for (int rep_ = 0; rep_ < args.reps[k]; ++rep_)

    if (IN(0)) { REP(0) { p0_prologue(F); if (N_LAUNCHES != 1) late_weights(F, F.vcu * 8 + F.wave, F.G * 8); } if (BOTH(0)) GRID_BAR(); }

    if (IN(1)) {
        ProbLinear P{F.XB, F.Win_t, DM, DM, DM}; SchedP1 S{F.G, F.vcu};
        EpiP1 E{F.rstd1, F.rope, F.qg, F.kg, F.UB, F.QB, F.KB, F.VB};
        REP(1) { pg8::gemm_phase(F.lds, P, S, E); }
        if (N_LAUNCHES == 1) { const int nfull = 643 % F.G;
            if (F.vcu >= nfull) late_weights(F, (F.vcu - nfull) * 8 + F.wave, (F.G - nfull) * 8); }
        if (BOTH(1)) GRID_BAR();
    }
    if (IN(2)) { REP(2) { p2_pool(F); } REP(7) { p2_attn(F); } if (BOTH(2)) GRID_BAR(); }
    if (IN(3)) {
        ProbLinear P{F.YMIX, F.Wout_t, DM, DM, DM}; SchedP3 S{F.G, F.vcu};
        EpiP3 E{F.XB, F.H1, F.ss2};
        REP(3) { pg8::gemm_phase(F.lds, P, S, E); }
        if (BOTH(3)) GRID_BAR();
    }
    if (IN(4)) { REP(4) { p4_route(F, rep_); } if (BOTH(4)) GRID_BAR(); }
    if (IN(5)) {
        moe_tables(F);
        ProbG1 P{F.H1, F.Wgu_t, (const LAS int*)(F.lds + TAB_TOK), DM, DM, DM}; SchedMoe S{(const LAS int*)(F.lds + TAB_HDR)};
        EpiG1 E{F.HID, (const LAS float*)(F.lds + TAB_RSTD), (const LAS float*)(F.lds + TAB_WLO), (const LAS float*)(F.lds + TAB_WHI)};
        REP(5) { pg8::gemm_phase(F.lds, P, S, E); }
        if (BOTH(5)) GRID_BAR();
    }
    if (IN(6)) {
        if (!IN(5)) moe_tables(F);
        ProbG2 P{F.HID, F.Wd_t, 512, 512, DEXP}; SchedMoe S{(const LAS int*)(F.lds + TAB_HDR)};
        EpiG2 E{F.out, F.H1, (const LAS int*)(F.lds + TAB_TOK)};
        REP(6) { pg8::gemm_phase(F.lds, P, S, E); }
    }
#undef IN
#undef BOTH
}

extern "C" void kernel_launch(void* const* d_in, const int* in_sizes, int n_in, void* d_out, int out_size, void* d_ws, size_t ws_size, hipStream_t stream) {
    static int grid = 0;
    if (grid == 0) {
        if (n_in != 16 || in_sizes[0] != T * DM || out_size != T * DM || ws_size < WS_END) { fprintf(stderr, "kernel_launch: unexpected shapes (n_in %d, in0 %d, out %d, ws %zu)\n", n_in, n_in > 0 ? in_sizes[0] : -1, out_size, ws_size); grid = -1; return; }
        int dev = 0, cus = 0, per_cu = 0;
        if (hipGetDevice(&dev) != hipSuccess || hipDeviceGetAttribute(&cus, hipDeviceAttributeMultiprocessorCount, dev) != hipSuccess) { grid = -1; return; }
        if (hipFuncSetAttribute((const void*)hymba_fwd, hipFuncAttributeMaxDynamicSharedMemorySize, LDS_BYTES) != hipSuccess) { fprintf(stderr, "kernel_launch: hipFuncSetAttribute failed\n"); grid = -1; return; }
        if (hipOccupancyMaxActiveBlocksPerMultiprocessor(&per_cu, (const void*)hymba_fwd, 512, LDS_BYTES) != hipSuccess || per_cu < 1)
            fprintf(stderr, "kernel_launch: occupancy query reports %d workgroups per CU\n", per_cu);
        (void)hipGetLastError();
        grid = cus;
    }
    if (grid < 0) return;
    if (hipMemsetAsync((char*)d_ws + WS_CTL, 0, CTL_ZERO_BYTES, stream) != hipSuccess) { fprintf(stderr, "kernel_launch: memset failed\n"); return; }
    Args a{};
    for (int i = 0; i < 16; ++i) a.in[i] = (const float*)d_in[i];
    a.out = (float*)d_out; a.ws = (unsigned char*)d_ws;
    for (int i = 0; i < 10; ++i) a.reps[i] = ((REPEAT_MASK >> i) & 1) ? 2 : 1;
    for (int li = 0; li < N_LAUNCHES; ++li) {
        a.ph_lo = (N_LAUNCHES == PER_PHASE) ? li : 0; a.ph_hi = (N_LAUNCHES == PER_PHASE) ? li + 1 : PER_PHASE;
        hipLaunchKernelGGL(hymba_fwd, dim3(grid), dim3(512), LDS_BYTES, stream, a);
        const hipError_t le = hipPeekAtLastError();
        if (le != hipSuccess) { fprintf(stderr, "kernel_launch: launch %d failed: %s\n", li, hipGetErrorName(le)); break; }
    }
}
```

```cpp
#include <hip/hip_runtime.h>
#include <cstdio>
#include <cstdint>

#ifndef MK_N_LAUNCHES
#define MK_N_LAUNCHES 1
#endif

#define LAS __attribute__((address_space(3)))
#define GAS __attribute__((address_space(1)))
typedef unsigned short bf16_t;
typedef short bf16x8 __attribute__((ext_vector_type(8)));
typedef float f32x4 __attribute__((ext_vector_type(4)));
typedef float f32x2 __attribute__((ext_vector_type(2)));
typedef unsigned u32x4 __attribute__((ext_vector_type(4)));
typedef unsigned u32x2 __attribute__((ext_vector_type(2)));

constexpr int DM = 1024, NB = 16, SEQ = 2048, NMETA = 16, LSEQ = SEQ + NMETA, LP = 2080;
constexpr int T = NB * SEQ;
constexpr int TM = T + 256;
constexpr int INW = 1280, NHEAD = 8, NKVH = 2, HD = 64, NEXP = 16, DEXP = 256, NPAIR = 24;
constexpr float EPS = 1e-6f;
constexpr float LOG2E = 1.4426950408889634f, QSCALE = 0.125f * LOG2E;
constexpr int MAXU = 4;

constexpr size_t MiB = 1u << 20;
constexpr size_t WS_CTL = 0, CTL_ZERO_BYTES = 1 * MiB;
constexpr size_t WS_WIN = 2 * MiB;
constexpr size_t WS_WOUT = 5 * MiB;
constexpr size_t WS_WGU = 8 * MiB;
constexpr size_t WS_WD = 24 * MiB;
constexpr size_t WS_WR = 32 * MiB;
constexpr size_t WS_ROPE = 33 * MiB;
constexpr size_t WS_RSTD1 = 34 * MiB;
constexpr size_t WS_RSTD2 = 35 * MiB;
constexpr size_t WS_WLO = 36 * MiB, WS_WHI = 37 * MiB;
constexpr size_t WS_SS2 = 38 * MiB;
constexpr size_t WS_LIST = 40 * MiB;
constexpr size_t WS_K = 44 * MiB;
constexpr size_t WS_V = 53 * MiB;
constexpr size_t WS_XB = 64 * MiB;
constexpr size_t WS_U = 130 * MiB;
constexpr size_t WS_Q = 164 * MiB;
constexpr size_t WS_YMIX = 196 * MiB;
constexpr size_t WS_H1 = 260 * MiB;
constexpr size_t WS_HID = 324 * MiB;
constexpr size_t WS_END = 364 * MiB;
constexpr int CW_CNT = 64;
constexpr int CW_BAR = 4096;

constexpr int RING_BYTES = 131072;
constexpr int TAB_OFF = RING_BYTES;
constexpr int TAB_TOK = TAB_OFF;
constexpr int TAB_RSTD = TAB_TOK + MAXU * 1024;
constexpr int TAB_WLO = TAB_RSTD + MAXU * 1024;
constexpr int TAB_WHI = TAB_WLO + MAXU * 1024;
constexpr int TAB_HDR = TAB_WHI + MAXU * 1024;
constexpr int MISC_OFF = TAB_HDR + 1024;
constexpr int LDS_BYTES = MISC_OFF + 128;
static_assert(LDS_BYTES <= 163840, "LDS map");

#define LDS_WAIT() asm volatile("s_waitcnt lgkmcnt(0)" ::: "memory")
#define VM_WAIT() asm volatile("s_waitcnt vmcnt(0)" ::: "memory")
__device__ __forceinline__ unsigned f2bf(float f) { unsigned u = __builtin_bit_cast(unsigned, f); return (u + 0x7fffu + ((u >> 16) & 1u)) >> 16; }
__device__ __forceinline__ unsigned pk2(float lo, float hi) { return f2bf(lo) | (f2bf(hi) << 16); }
__device__ __forceinline__ float bflo(unsigned w) { return __builtin_bit_cast(float, w << 16); }
__device__ __forceinline__ float bfhi(unsigned w) { return __builtin_bit_cast(float, w & 0xffff0000u); }
__device__ __forceinline__ float bf1(bf16_t h) { return __builtin_bit_cast(float, (unsigned)h << 16); }
__device__ __forceinline__ float wave_sum(float v) {
#pragma unroll
    for (int o = 1; o < 64; o <<= 1) v += __shfl_xor(v, o);
    return v;
}
__device__ __forceinline__ float wave_max(float v) {
#pragma unroll
    for (int o = 1; o < 64; o <<= 1) v = fmaxf(v, __shfl_xor(v, o));
    return v;
}

namespace pg8 {
constexpr int BM = 256, BK = 64, HALF = 128, HTB = HALF * BK * 2, STAGE_BYTES = 8 * HTB;
__host__ __device__ __forceinline__ int lds_byte(int r, int c) { const int st = (r >> 4) * 2 + (c >> 5), rr = r & 15, cc = c & 31, ob = rr * 64 + cc * 2; return st * 1024 + (ob ^ (((ob >> 9) & 1) << 5)); }
__host__ __device__ __forceinline__ void stage_rc(int b, int& R, int& C) { const int st = b / 1024, sb = b % 1024, swz = sb ^ (((sb >> 9) & 1) << 5); R = (st >> 1) * 16 + swz / 64; C = (st & 1) * 32 + (swz % 64) / 2; }
__host__ __device__ __forceinline__ int perm32(int rho) { const int n = rho >> 4, i = rho & 15; return 8 * (i >> 2) + 4 * n + (i & 3); }

struct Unit { int pm, pn, ui, x0, x1, nv; };
__device__ __forceinline__ unsigned cvt_pk_bf16(float lo, float hi) { unsigned r; asm volatile("v_cvt_pk_bf16_f32 %0, %1, %2" : "=v"(r) : "v"(lo), "v"(hi)); return r; }

template <class Prob, class Epi, class Sched>
__device__ __forceinline__ void gemm_phase(LAS unsigned char* lds, const Prob& P, const Sched& S, const Epi& E) {
    int tid_ = threadIdx.x; asm volatile("" : "+v"(tid_));
    const int tid = tid_, wid = __builtin_amdgcn_readfirstlane(tid >> 6), lane = tid & 63, wr = wid >> 2, wc = wid & 3, fr = lane & 15, fq = lane >> 4;
    const int nt = P.K / BK;
    int Rp[2], Cp[2]; unsigned voffB[2];
#pragma unroll
    for (int i = 0; i < 2; ++i) { stage_rc(tid * 16 + i * 8192, Rp[i], Cp[i]); const int Rb = Epi::PERM ? ((Rp[i] & ~31) + perm32(Rp[i] & 31)) : Rp[i];
        voffB[i] = (unsigned)(Rb * P.ldb + Cp[i]) * 2u; }
    const size_t kstep = (size_t)(BK * 2);
    const size_t hstepB = (size_t)HALF * P.ldb * 2;
    const unsigned ldsw = (unsigned)wid * 1024u;
    const int aoff = lds_byte(wr * 64 + fr, fq * 8), boff = lds_byte(wc * 32 + fr, fq * 8);
#define PG8_SA(b, h) (((b) * 2 + (h)) * HTB)
#define PG8_SB(b, h) ((4 + (b) * 2 + (h)) * HTB)
#define PG8_STAGE(bufoff, gbase, voff) do { _Pragma("unroll") for (int _i = 0; _i < 2; ++_i) \
        __builtin_amdgcn_global_load_lds((const unsigned*)((const char*)(gbase) + (voff)[_i]), (LAS unsigned*)(lds + (bufoff) + ldsw + _i * 8192), 16, 0, 0); } while (0)
#define PG8_LDA(dst, b, h) do { _Pragma("unroll") for (int m = 0; m < 4; ++m) _Pragma("unroll") for (int k = 0; k < 2; ++k) dst[m][k] = *(const LAS bf16x8*)(lds + PG8_SA(b, h) + aoff + m * 2048 + k * 1024); } while (0)
#define PG8_LDB(dst, b, h) do { _Pragma("unroll") for (int n = 0; n < 2; ++n) _Pragma("unroll") for (int k = 0; k < 2; ++k) dst[n][k] = *(const LAS bf16x8*)(lds + PG8_SB(b, h) + boff + n * 2048 + k * 1024); } while (0)
#define PG8_MMA(ai, bj, At, Bt) do { __builtin_amdgcn_s_setprio(1); _Pragma("unroll") for (int m = 0; m < 4; ++m) _Pragma("unroll") for (int n = 0; n < 2; ++n) _Pragma("unroll") for (int k = 0; k < 2; ++k) \
        acc[ai][bj][m][n] = __builtin_amdgcn_mfma_f32_16x16x32_bf16(Bt[n][k], At[m][k], acc[ai][bj][m][n], 0, 0, 0); __builtin_amdgcn_s_setprio(0); } while (0)
#define PG8_WAIT_V(n) asm volatile("s_waitcnt vmcnt(" #n ")" ::: "memory")
#define PG8_WAIT_L(n) asm volatile("s_waitcnt lgkmcnt(" #n ")" ::: "memory")
#define PG8_BAR __builtin_amdgcn_s_barrier()
#define PG8_SCHED __builtin_amdgcn_sched_barrier(0)
    Unit cur, nxt; int ui = 0;
    if (!S.next(0, cur)) return;
    f32x4 acc[2][2][4][2];
#pragma unroll
    for (int a = 0; a < 2; ++a)
#pragma unroll
        for (int b = 0; b < 2; ++b)
#pragma unroll
            for (int m = 0; m < 4; ++m)
#pragma unroll
                for (int n = 0; n < 2; ++n) acc[a][b][m][n] = (f32x4){0.f, 0.f, 0.f, 0.f};
    bf16x8 At[4][2], B0[2][2], B1[2][2];
    unsigned voC[2][2], voN[2][2];
    P.a_voff(cur, Rp, Cp, voC);
    const char* cA = P.a_base(cur);
    {
        const char* b0 = P.b_tile(cur, 0); const char* b1 = P.b_tile(cur, 1);
        PG8_STAGE(PG8_SB(0, 0), b0, voffB); PG8_STAGE(PG8_SB(0, 1), b0 + hstepB, voffB); PG8_STAGE(PG8_SA(0, 0), cA, voC[0]); PG8_STAGE(PG8_SA(0, 1), cA, voC[1]);
        if (wr == 1) PG8_BAR;
        PG8_WAIT_V(2); PG8_BAR;
        PG8_STAGE(PG8_SB(1, 0), b1, voffB); PG8_STAGE(PG8_SA(1, 0), cA + kstep, voC[0]); PG8_STAGE(PG8_SB(1, 1), b1 + hstepB, voffB);
        PG8_WAIT_V(6); PG8_BAR;
    }
    for (;;) {
        const bool has_next = S.next(ui + 1, nxt);
        if (!has_next) nxt = cur;
        if constexpr (Prob::GATHER) P.a_voff(nxt, Rp, Cp, voN);
        const char* nA = P.a_base(nxt);
#pragma clang loop unroll(disable)
        for (int t = 0; t < nt; t += 2) {
            const bool last = (t == nt - 2);
            const char* a1 = cA + (size_t)(t + 1) * kstep;
            const char* a2 = last ? nA : cA + (size_t)(t + 2) * kstep;
            const char* a3 = a2 + kstep;
            const char* b2 = last ? P.b_tile(nxt, 0) : P.b_tile(cur, t + 2);
            const char* b3 = last ? P.b_tile(nxt, 1) : P.b_tile(cur, t + 3);
            unsigned v2[2][2];
#pragma unroll
            for (int h = 0; h < 2; ++h)
#pragma unroll
                for (int i = 0; i < 2; ++i) { if constexpr (Prob::GATHER) v2[h][i] = last ? voN[h][i] : voC[h][i]; else v2[h][i] = voC[h][i]; }
            PG8_LDB(B0, 0, 0); PG8_LDB(B1, 0, 1); PG8_SCHED; PG8_LDA(At, 0, 0); PG8_STAGE(PG8_SA(1, 1), a1, voC[1]);
            PG8_WAIT_V(8); PG8_WAIT_L(0); PG8_BAR; PG8_MMA(0, 0, At, B0); PG8_MMA(0, 1, At, B1); PG8_BAR; PG8_SCHED;
            PG8_LDA(At, 0, 1); PG8_STAGE(PG8_SB(0, 0), b2, voffB); PG8_STAGE(PG8_SB(0, 1), b2 + hstepB, voffB); PG8_STAGE(PG8_SA(0, 0), a2, v2[0]);
            PG8_WAIT_V(8); PG8_WAIT_L(0); PG8_BAR; PG8_MMA(1, 0, At, B0); PG8_MMA(1, 1, At, B1); PG8_BAR; PG8_SCHED;
            PG8_LDB(B0, 1, 0); PG8_LDB(B1, 1, 1); PG8_SCHED; PG8_LDA(At, 1, 0); PG8_STAGE(PG8_SA(0, 1), a2, v2[1]);
            PG8_WAIT_V(8); PG8_WAIT_L(0); PG8_BAR; PG8_MMA(0, 0, At, B0); PG8_MMA(0, 1, At, B1); PG8_BAR; PG8_SCHED;
            PG8_LDA(At, 1, 1); PG8_STAGE(PG8_SB(1, 0), b3, voffB); PG8_STAGE(PG8_SB(1, 1), b3 + hstepB, voffB); PG8_STAGE(PG8_SA(1, 0), a3, v2[0]);
            PG8_WAIT_V(8); PG8_WAIT_L(0); PG8_BAR; PG8_MMA(1, 0, At, B0); PG8_MMA(1, 1, At, B1); PG8_BAR; PG8_SCHED;
        }
        if (wr == 0) PG8_BAR;
        E(acc, cur, wr, wc, fr, fq);
        if (!has_next) break;
#pragma unroll
        for (int a = 0; a < 2; ++a)
#pragma unroll
            for (int b = 0; b < 2; ++b)
#pragma unroll
                for (int m = 0; m < 4; ++m)
#pragma unroll
                    for (int n = 0; n < 2; ++n) acc[a][b][m][n] = (f32x4){0.f, 0.f, 0.f, 0.f};
        cur = nxt; cA = nA; ++ui;
#pragma unroll
        for (int h = 0; h < 2; ++h)
#pragma unroll
            for (int i = 0; i < 2; ++i) { if constexpr (Prob::GATHER) voC[h][i] = voN[h][i]; }
        if (wr == 1) PG8_BAR;
    }
    PG8_WAIT_V(0);
    PG8_BAR;
#undef PG8_SA
#undef PG8_SB
#undef PG8_STAGE
#undef PG8_LDA
#undef PG8_LDB
#undef PG8_MMA
#undef PG8_WAIT_V
#undef PG8_WAIT_L
#undef PG8_BAR
#undef PG8_SCHED
}
}
using pg8::Unit;

typedef GAS unsigned gu32;
#define XB_TMO      128
#define XB_XCNT(j)  (256  + 64 * (j))
#define XB_XSUB(j)  (1280 + 64 * (j))
#define XB_XGEN(j)  (2304 + 64 * (j))
#define XB_TOP      3328
#define XB_TOPGEN   3392
#define XCD_BAR_WORDS 3456
#define XB_SPIN_CAP (1u << 18)
__device__ __forceinline__ unsigned xb_ld(unsigned* p)              { return __hip_atomic_load(p, __ATOMIC_RELAXED, __HIP_MEMORY_SCOPE_AGENT); }
__device__ __forceinline__ unsigned xb_add(unsigned* p, unsigned v) { return __hip_atomic_fetch_add(p, v, __ATOMIC_RELAXED, __HIP_MEMORY_SCOPE_AGENT); }
__device__ __forceinline__ unsigned xb_xcc_id() { return (unsigned)__builtin_amdgcn_s_getreg((3 << 11) | 20) & 0xFu; }
#define XB_SPIN(cond, bar) do { unsigned _sp = 0; while (cond) { __builtin_amdgcn_s_sleep(1); \
    if ((++_sp & 255u) == 0u) { if (xb_ld(&(bar)[XB_TMO])) break; if (_sp > XB_SPIN_CAP) { atomicAdd(&(bar)[XB_TMO], 1u); break; } } } } while (0)
struct XcdBarrier { unsigned* bar; unsigned x; volatile LAS unsigned* st; };
__device__ __forceinline__ XcdBarrier xcd_barrier_post(unsigned* bar, volatile LAS unsigned* st) {
    XcdBarrier b; b.bar = bar; b.x = xb_xcc_id(); b.st = st;
    if (threadIdx.x == 0) (void)xb_add(&bar[XB_XCNT(b.x)], 1u);
    return b;
}
__device__ __forceinline__ void xcd_barrier_complete(unsigned* bar, unsigned x, unsigned& nloc, unsigned& nx) {
    const unsigned G = gridDim.x * gridDim.y * gridDim.z;
    unsigned sum, cnt, mine, sp = 0u;
    for (;;) {
        sum = 0u; cnt = 0u; mine = 0u;
#pragma unroll
        for (unsigned j = 0; j < 16; ++j) { const unsigned c = xb_ld(&bar[XB_XCNT(j)]); sum += c; cnt += (c > 0u) ? 1u : 0u; mine = (j == x) ? c : mine; }
        if (sum == G) break;
        __builtin_amdgcn_s_sleep(1);
        if ((++sp & 255u) == 0u) { if (xb_ld(&bar[XB_TMO])) break; if (sp > XB_SPIN_CAP) { atomicAdd(&bar[XB_TMO], 1u); break; } }
    }
    nloc = mine > 0u ? mine : 1u; nx = cnt > 0u ? cnt : 1u;
}
__device__ __forceinline__ void xcd_barrier(const XcdBarrier& b) {
    asm volatile("s_waitcnt vmcnt(0)" ::: "memory");
    __syncthreads();
    if (threadIdx.x == 0) {
        unsigned* bar = b.bar;
        __builtin_amdgcn_s_waitcnt(0);
        unsigned nloc = b.st[0], nx = b.st[1];
        if (nloc == 0u) { xcd_barrier_complete(bar, b.x, nloc, nx); b.st[0] = nloc; b.st[1] = nx; }
        const unsigned old = xb_add(&bar[XB_XSUB(b.x)], 1u);
        const unsigned gen = old / nloc;
        if (old + 1u == (gen + 1u) * nloc) {
            __builtin_amdgcn_fence(__ATOMIC_RELEASE, "agent");
            asm volatile("s_waitcnt vmcnt(0)" ::: "memory");
            const unsigned og = xb_add(&bar[XB_TOP], 1u);
            const unsigned tg = og / nx;
            if (og + 1u == (tg + 1u) * nx) xb_add(&bar[XB_TOPGEN], 1u);
            else XB_SPIN(xb_ld(&bar[XB_TOPGEN]) == tg, bar);
            __builtin_amdgcn_fence(__ATOMIC_ACQUIRE, "agent");
            xb_add(&bar[XB_XGEN(b.x)], 1u);
            asm volatile("s_waitcnt vmcnt(0)" ::: "memory");
        } else {
            XB_SPIN(xb_ld(&bar[XB_XGEN(b.x)]) == gen, bar);
            __builtin_amdgcn_fence(__ATOMIC_ACQUIRE, "agent");
            asm volatile("s_waitcnt vmcnt(0)" ::: "memory");
        }
    }
    __syncthreads();
}

struct Frame {
    LAS unsigned char* lds;
    volatile LAS unsigned* MISC;
    unsigned* ctl;
    int tid, lane, wave, vcu, G;
    const float *x, *meta, *g1, *win, *wpool, *pscale, *qg, *kg, *sinks, *wout, *g2, *wgr, *wer, *wgate, *wup, *wdown;
    float* out;
    bf16_t *Win_t, *Wout_t, *Wgu_t, *Wd_t, *Wr_t, *XB, *UB, *QB, *KB, *VB, *YMIX, *H1, *HID;
    float *rope, *rstd1, *rstd2, *wlo, *whi, *ss2;
    int* list;
};

__device__ __forceinline__ void transpose_item(const float* W, int ldw, int k0, int n0, const float* scale, bf16_t* dst, int ldd, LAS float* scr, int lane) {
    const int c4 = lane & 7, kr = lane >> 3;
    f32x4 v[8];
#pragma unroll
    for (int i = 0; i < 8; ++i) v[i] = *(const f32x4*)(W + (size_t)(k0 + 8 * i + kr) * ldw + n0 + 4 * c4);
#pragma unroll
    for (int i = 0; i < 8; ++i) { const int kk = 8 * i + kr; f32x4 t = v[i]; if (scale) t = t * scale[k0 + kk];
        LAS float* d = scr + kk * 33 + 4 * c4; d[0] = t[0]; d[1] = t[1]; d[2] = t[2]; d[3] = t[3]; }
    LDS_WAIT(); asm volatile("" ::: "memory");
    const int c = lane & 7;
#pragma unroll
    for (int j = 0; j < 4; ++j) { const int n = (lane >> 3) + 8 * j; const LAS float* s = scr + (8 * c) * 33 + n;
        u32x4 o; o.x = pk2(s[0 * 33], s[1 * 33]); o.y = pk2(s[2 * 33], s[3 * 33]); o.z = pk2(s[4 * 33], s[5 * 33]); o.w = pk2(s[6 * 33], s[7 * 33]);
        *(u32x4*)(dst + (size_t)n * ldd + 8 * c) = o; }
    LDS_WAIT(); asm volatile("" ::: "memory");
}
__device__ __forceinline__ void row_to_bf16(const float* xrow, bf16_t* orow, float* rstd_out, int lane) {
    const f32x4* xr = (const f32x4*)xrow + lane;
    f32x4 v[4]; float s = 0.f;
#pragma unroll
    for (int j = 0; j < 4; ++j) { v[j] = xr[64 * j]; s += (v[j].x * v[j].x + v[j].y * v[j].y) + (v[j].z * v[j].z + v[j].w * v[j].w); }
    s = wave_sum(s);
    u32x2* o8 = (u32x2*)orow + lane;
#pragma unroll
    for (int j = 0; j < 4; ++j) { u32x2 w; w.x = pk2(v[j].x, v[j].y); w.y = pk2(v[j].z, v[j].w); o8[64 * j] = w; }
    if (lane == 0) *rstd_out = 1.0f / sqrtf(s * (1.0f / DM) + EPS);
}

__device__ __forceinline__ void late_weights(Frame& F, int gw, int NGW) {
    LAS float* scr = (LAS float*)(F.lds + F.wave * 16384);
    const int lane = F.lane;
    constexpr int I_GU = 32 * 128, I_D = 16 * 128, I_O = 8 * 32;
    constexpr int NITEMS = I_GU + I_D + I_O;
    for (int it = gw; it < NITEMS; it += NGW) {
        int r = it;
        if (r < I_GU) { const int mat = r / 128, rr = r % 128, kb = rr / 8, fg = rr % 8, e = mat >> 1, isup = mat & 1;
            const float* W = (isup ? F.wup : F.wgate) + (size_t)e * DM * DEXP;
            const int drow = 256 * (fg >> 2) + 128 * isup + 32 * (fg & 3);
            transpose_item(W, DEXP, kb * 64, fg * 32, F.g2, F.Wgu_t + ((size_t)e * 512 + drow) * DM + kb * 64, DM, scr, lane); continue; }
        r -= I_GU;
        if (r < I_D) { const int e = r / 128, rr = r % 128, kb = rr / 32, nb = rr % 32;
            transpose_item(F.wdown + (size_t)e * DEXP * DM, DM, kb * 64, nb * 32, nullptr, F.Wd_t + ((size_t)e * DM + nb * 32) * DEXP + kb * 64, DEXP, scr, lane); continue; }
        r -= I_D;
        { const int kb = r / 32, nb = r % 32;
            transpose_item(F.wout + (size_t)512 * DM, DM, kb * 64, nb * 32, nullptr, F.Wout_t + (size_t)(nb * 32) * DM + 512 + kb * 64, DM, scr, lane); }
    }
    for (int it = gw; it < 1024; it += NGW) {
        const int g = it >> 8, cc = (it >> 4) & 15, nb = it & 15, n = nb * 64 + lane;
        float a[8];
#pragma unroll
        for (int j = 0; j < 8; ++j) a[j] = 0.f;
        const float* wp = F.wpool + ((size_t)g * 128 + cc * 8) * 128;
#pragma unroll 4
        for (int d = 0; d < 128; ++d) {
            const float wo = F.wout[(size_t)(g * 128 + d) * DM + n] * F.pscale[g * 128 + d];
#pragma unroll
            for (int j = 0; j < 8; ++j) a[j] += wp[j * 128 + d] * wo;
        }
        u32x4 o; o.x = pk2(a[0], a[1]); o.y = pk2(a[2], a[3]); o.z = pk2(a[4], a[5]); o.w = pk2(a[6], a[7]);
        *(u32x4*)(F.Wout_t + (size_t)n * DM + g * 128 + cc * 8) = o;
    }
    for (int i = gw * 64 + lane; i < 32 * DM; i += NGW * 64) {
        const int j = i >> 10, k = i & 1023; float v = 0.f;
        if (j < 16) v = F.wer[k * 16 + j] * F.g2[k]; else if (j < 20) v = F.wgr[k * 4 + (j - 16)] * F.g2[k];
        F.Wr_t[i] = (bf16_t)f2bf(v);
    }
}
__device__ __forceinline__ void p0_prologue(Frame& F) {
    LAS float* scr = (LAS float*)(F.lds + F.wave * 16384);
    const int gw = F.vcu * 8 + F.wave, NGW = F.G * 8, lane = F.lane;
    for (int r = gw; r < 16 * 40; r += NGW) {
        const int kb = r / 40, sg = r % 40; int drow;
        if (sg < 16) drow = sg * 32;
        else if (sg < 32) { const int qc = (sg - 16) * 32, head = qc >> 6, half = (qc >> 5) & 1; drow = 256 * (2 + (head >> 2)) + 128 * half + 32 * (head & 3); }
        else { const int kc = (sg - 32) * 32, hh = kc >> 6, half = (kc >> 5) & 1; drow = 1024 + 128 * half + 32 * hh; }
        transpose_item(F.win, INW, kb * 64, sg * 32, F.g1, F.Win_t + (size_t)drow * DM + kb * 64, DM, scr, lane);
    }
    for (int i = gw * 64 + lane; i < LSEQ * 8; i += NGW * 64) {
        const int pos = i >> 3, fi = i & 7;
        double f = 1.0;
        if (fi == 1) f = 0.19392274474868576; if (fi == 2) f = 0.03760603093086393; if (fi == 3) f = 0.007292664737217109; if (fi == 4) f = 0.001414213562373095;
        if (fi == 5) f = 0.0002742481756762073; if (fi == 6) f = 5.318295896944988e-05; if (fi == 7) f = 1.031338537721246e-05;
        const double rev = (double)pos * f * 0.15915494309189535;
        const double fr = rev - __builtin_floor(rev + 0.5);
        const double qd = __builtin_floor(fr * 4.0 + 0.5);
        const double tt = (fr - qd * 0.25) * 6.283185307179586;
        const double t2 = tt * tt;
        const double sn = tt * (1.0 + t2 * (-1.0 / 6 + t2 * (1.0 / 120 + t2 * (-1.0 / 5040 + t2 * (1.0 / 362880 + t2 * (-1.0 / 39916800 + t2 * (1.0 / 6227020800.0)))))));
        const double cs = 1.0 + t2 * (-0.5 + t2 * (1.0 / 24 + t2 * (-1.0 / 720 + t2 * (1.0 / 40320 + t2 * (-1.0 / 3628800 + t2 * (1.0 / 479001600.0))))));
        const int qi = ((int)qd) & 3;
        const double c4 = (qi == 0) ? cs : (qi == 1) ? -sn : (qi == 2) ? -cs : sn;
        const double s4 = (qi == 0) ? sn : (qi == 1) ? cs : (qi == 2) ? -sn : -cs;
        F.rope[2 * i] = (float)c4; F.rope[2 * i + 1] = (float)s4;
    }
    for (int m = gw; m < T; m += 2 * NGW) {
        const int m2 = m + NGW;
        const f32x4* xa = (const f32x4*)(F.x + (size_t)m * DM) + lane; const f32x4* xb = (const f32x4*)(F.x + (size_t)(m2 < T ? m2 : m) * DM) + lane;
        f32x4 va[4], vb[4]; float sa = 0.f, sb = 0.f;
#pragma unroll
        for (int j = 0; j < 4; ++j) { va[j] = xa[64 * j]; vb[j] = xb[64 * j]; }
#pragma unroll
        for (int j = 0; j < 4; ++j) { sa += (va[j].x * va[j].x + va[j].y * va[j].y) + (va[j].z * va[j].z + va[j].w * va[j].w); sb += (vb[j].x * vb[j].x + vb[j].y * vb[j].y) + (vb[j].z * vb[j].z + vb[j].w * vb[j].w); }
        sa = wave_sum(sa); sb = wave_sum(sb);
        u32x2* oa = (u32x2*)(F.XB + (size_t)m * DM) + lane; u32x2* ob = (u32x2*)(F.XB + (size_t)m2 * DM) + lane;
#pragma unroll
        for (int j = 0; j < 4; ++j) { u32x2 w; w.x = pk2(va[j].x, va[j].y); w.y = pk2(va[j].z, va[j].w); oa[64 * j] = w; }
        if (lane == 0) F.rstd1[m] = 1.0f / sqrtf(sa * (1.0f / DM) + EPS);
        if (m2 < T) {
#pragma unroll
            for (int j = 0; j < 4; ++j) { u32x2 w; w.x = pk2(vb[j].x, vb[j].y); w.y = pk2(vb[j].z, vb[j].w); ob[64 * j] = w; }
            if (lane == 0) F.rstd1[m2] = 1.0f / sqrtf(sb * (1.0f / DM) + EPS);
        }
    }
    for (int m = T + gw; m < T + NMETA; m += NGW) row_to_bf16(F.meta + (size_t)(m - T) * DM, F.XB + (size_t)m * DM, F.rstd1 + m, lane);
    for (int i = gw * 64 + lane; i < (256 - NMETA) * DM / 8; i += NGW * 64) ((u32x4*)(F.XB + (size_t)(T + NMETA) * DM))[i] = (u32x4){0u, 0u, 0u, 0u};
    for (int i = gw * 64 + lane; i < 256 - NMETA; i += NGW * 64) F.rstd1[T + NMETA + i] = 0.f;
    for (int i = gw * 64 + lane; i < 32 * 16 * 8; i += NGW * 64) { const int bh = i >> 7, r = (i >> 3) & 15, c = i & 7;
        *(u32x4*)(F.KB + ((size_t)bh * LP + LSEQ + r) * HD + c * 8) = (u32x4){0u, 0u, 0u, 0u}; }
    for (int i = gw * 64 + lane; i < 32 * 64 * 2; i += NGW * 64) { const int row = i >> 1, c = i & 1;
        *(u32x4*)(F.VB + (size_t)row * LP + LSEQ + c * 8) = (u32x4){0u, 0u, 0u, 0u}; }
}

struct SchedP1 { int G, c;
    __device__ __forceinline__ bool next(int i, Unit& u) const { const int L = i * G + c; if (L >= 643) return false;
        if (L < 640) { u.pm = L / 5; u.pn = L % 5; } else { u.pm = 128; u.pn = (L == 642) ? 4 : (L - 640); }
        u.ui = 0; u.x0 = 0; u.x1 = 0; u.nv = 256; return true; } };
struct SchedP3 { int G, c;
    __device__ __forceinline__ bool next(int i, Unit& u) const { const int L = i * G + c; if (L >= 512) return false; u.pm = L >> 2; u.pn = L & 3; u.ui = 0; u.x0 = 0; u.x1 = 0; u.nv = 256; return true; } };
struct SchedMoe { const LAS int* hdr;
    __device__ __forceinline__ bool next(int i, Unit& u) const {
        const int n = __builtin_amdgcn_readfirstlane(hdr[MAXU * 8]); if (i >= n) return false;
        u.pm = __builtin_amdgcn_readfirstlane(hdr[i * 8 + 0]); u.pn = __builtin_amdgcn_readfirstlane(hdr[i * 8 + 1]);
        u.x0 = __builtin_amdgcn_readfirstlane(hdr[i * 8 + 2]); u.x1 = __builtin_amdgcn_readfirstlane(hdr[i * 8 + 3]);
        u.nv = __builtin_amdgcn_readfirstlane(hdr[i * 8 + 4]); u.ui = i; return true; } };

struct ProbLinear { static constexpr bool GATHER = false; const bf16_t* A; const bf16_t* Bt; int K, lda, ldb;
    __device__ __forceinline__ const char* a_base(const Unit& u) const { return (const char*)A + (size_t)u.pm * 256 * lda * 2; }
    __device__ __forceinline__ void a_voff(const Unit&, const int (&Rp)[2], const int (&Cp)[2], unsigned (&vo)[2][2]) const {
#pragma unroll
        for (int h = 0; h < 2; ++h)
#pragma unroll
            for (int i = 0; i < 2; ++i) vo[h][i] = (unsigned)((h * 128 + Rp[i]) * lda + Cp[i]) * 2u; }
    __device__ __forceinline__ const char* b_tile(const Unit& u, int kt) const { return (const char*)Bt + (size_t)u.pn * 256 * ldb * 2 + (size_t)kt * 128; } };
struct ProbG1 { static constexpr bool GATHER = true; const bf16_t* A; const bf16_t* Wgu; const LAS int* tokT; int K, lda, ldb;
    __device__ __forceinline__ const char* a_base(const Unit&) const { return (const char*)A; }
    __device__ __forceinline__ void a_voff(const Unit& u, const int (&Rp)[2], const int (&Cp)[2], unsigned (&vo)[2][2]) const {
#pragma unroll
        for (int h = 0; h < 2; ++h)
#pragma unroll
            for (int i = 0; i < 2; ++i) { const int tok = tokT[u.ui * 256 + h * 128 + Rp[i]]; vo[h][i] = (unsigned)(tok * DM + Cp[i]) * 2u; } }
    __device__ __forceinline__ const char* b_tile(const Unit& u, int kt) const { const int e = (u.pn < 2) ? u.x0 : u.x1;
        return (const char*)Wgu + ((size_t)e * 512 + (u.pn & 1) * 256) * DM * 2 + (size_t)kt * 128; } };
struct ProbG2 { static constexpr bool GATHER = false; const bf16_t* A; const bf16_t* Wd; int K, lda, ldb;
    __device__ __forceinline__ const char* a_base(const Unit& u) const { return (const char*)A + (size_t)u.pm * 256 * 512 * 2; }
    __device__ __forceinline__ void a_voff(const Unit&, const int (&Rp)[2], const int (&Cp)[2], unsigned (&vo)[2][2]) const {
#pragma unroll
        for (int h = 0; h < 2; ++h)
#pragma unroll
            for (int i = 0; i < 2; ++i) vo[h][i] = (unsigned)((h * 128 + Rp[i]) * 512 + Cp[i]) * 2u; }
    __device__ __forceinline__ const char* b_tile(const Unit& u, int kt) const { const int e = (kt < 4) ? u.x0 : u.x1;
        return (const char*)Wd + ((size_t)e * DM + u.pn * 256) * DEXP * 2 + (size_t)(kt & 3) * 128; } };

struct EpiP1 { static constexpr bool PERM = true;
    const float* rstd1; const float* rope; const float* qg; const float* kg; bf16_t *UB, *QB, *KB, *VB;
    __device__ __forceinline__ void operator()(const f32x4 (&acc)[2][2][4][2], const Unit& u, int wr, int wc, int fr, int fq) const {
        asm volatile("" : "+v"(fr), "+v"(fq));
        const bool meta = (u.pm == 128);
#pragma unroll
        for (int ai = 0; ai < 2; ++ai)
#pragma unroll
            for (int m = 0; m < 4; ++m) {
                const int rl = ai * 128 + wr * 64 + m * 16 + fr, grow = u.pm * 256 + rl;
                const float rs = rstd1[grow];
                const bool valid = !meta || rl < NMETA;
                const int b = grow >> 11, pos = meta ? rl : (grow & 2047) + NMETA;
                f32x4 v[2][2];
#pragma unroll
                for (int bj = 0; bj < 2; ++bj)
#pragma unroll
                    for (int n = 0; n < 2; ++n) v[bj][n] = acc[ai][bj][m][n] * rs;
                if (u.pn < 2) {
#pragma unroll
                    for (int bj = 0; bj < 2; ++bj) { u32x4 w; w.x = pg8::cvt_pk_bf16(v[bj][0][0], v[bj][0][1]); w.y = pg8::cvt_pk_bf16(v[bj][0][2], v[bj][0][3]); w.z = pg8::cvt_pk_bf16(v[bj][1][0], v[bj][1][1]); w.w = pg8::cvt_pk_bf16(v[bj][1][2], v[bj][1][3]);
                        const int col = u.pn * 256 + bj * 128 + wc * 32 + fq * 8;
                        if (!meta) *(u32x4*)(UB + ((size_t)b * LSEQ + pos) * 512 + col) = w;
                        else if (valid) { for (int bb = 0; bb < NB; ++bb) *(u32x4*)(UB + ((size_t)bb * LSEQ + pos) * 512 + col) = w; } }
                } else {
                    const bool isv = (u.pn == 4) && (wc >= 2);
                    if (!isv) {
                        float ss = 0.f;
#pragma unroll
                        for (int bj = 0; bj < 2; ++bj)
#pragma unroll
                            for (int n = 0; n < 2; ++n) ss += (v[bj][n][0] * v[bj][n][0] + v[bj][n][1] * v[bj][n][1]) + (v[bj][n][2] * v[bj][n][2] + v[bj][n][3] * v[bj][n][3]);
                        ss += __shfl_xor(ss, 16); ss += __shfl_xor(ss, 32);
                        const float rn = 1.0f / sqrtf(ss * (1.0f / HD) + EPS);
                        const float* gp = (u.pn == 4) ? kg : qg;
#pragma unroll
                        for (int bj = 0; bj < 2; ++bj)
#pragma unroll
                            for (int n = 0; n < 2; ++n) { const f32x4 gv = *(const f32x4*)(gp + 32 * bj + 8 * fq + 4 * n); v[bj][n] = v[bj][n] * rn * gv; }
#pragma unroll
                        for (int n = 0; n < 2; ++n) {
                            const f32x4 cs0 = *(const f32x4*)(rope + ((size_t)pos * 8 + 4 * n) * 2), cs1 = *(const f32x4*)(rope + ((size_t)pos * 8 + 4 * n) * 2 + 4);
                            const float c[4] = {cs0[0], cs0[2], cs1[0], cs1[2]}, s[4] = {cs0[1], cs0[3], cs1[1], cs1[3]};
#pragma unroll
                            for (int jj = 0; jj < 4; ++jj) { const float mine = v[0][n][jj], oth = __shfl_xor(mine, 16);
                                const float r = (fq == 0) ? (mine * c[jj] - oth * s[jj]) : (mine * c[jj] + oth * s[jj]);
                                v[0][n][jj] = (fq < 2) ? r : mine; }
                        }
                        if (u.pn != 4) {
#pragma unroll
                            for (int bj = 0; bj < 2; ++bj)
#pragma unroll
                                for (int n = 0; n < 2; ++n) v[bj][n] = v[bj][n] * QSCALE;
                        }
                    }
                    if (isv) {
                        const int pp = (pos & ~15) | (((pos >> 2) & 1) << 3) | (((pos >> 3) & 1) << 2) | (pos & 3); const int hh = wc & 1;
#pragma unroll
                        for (int bj = 0; bj < 2; ++bj)
#pragma unroll
                            for (int n = 0; n < 2; ++n)
#pragma unroll
                                for (int jj = 0; jj < 4; ++jj) { const int d = 32 * bj + 8 * fq + 4 * n + jj; const bf16_t hv = (bf16_t)f2bf(v[bj][n][jj]);
                                    if (!meta) VB[(((size_t)b * 2 + hh) * HD + d) * LP + pp] = hv;
                                    else if (valid) { for (int bb = 0; bb < NB; ++bb) VB[(((size_t)bb * 2 + hh) * HD + d) * LP + pp] = hv; } }
                    } else {
#pragma unroll
                    for (int bj = 0; bj < 2; ++bj) { u32x4 w; w.x = pg8::cvt_pk_bf16(v[bj][0][0], v[bj][0][1]); w.y = pg8::cvt_pk_bf16(v[bj][0][2], v[bj][0][3]); w.z = pg8::cvt_pk_bf16(v[bj][1][0], v[bj][1][1]); w.w = pg8::cvt_pk_bf16(v[bj][1][2], v[bj][1][3]);
                        const int d0 = 32 * bj + 8 * fq;
                        if (u.pn != 4) { const int head = 4 * (u.pn - 2) + wc; *(u32x4*)(QB + (size_t)grow * 512 + head * HD + d0) = w; }
                        else { const int hh = wc & 1;
                            if (!meta) *(u32x4*)(KB + (((size_t)b * 2 + hh) * LP + pos) * HD + d0) = w;
                            else if (valid) { for (int bb = 0; bb < NB; ++bb) *(u32x4*)(KB + (((size_t)bb * 2 + hh) * LP + pos) * HD + d0) = w; } } }
                    }
                }
            }
    }
};
struct EpiP3 { static constexpr bool PERM = true;
    const bf16_t* xb; bf16_t* H1; float* ss2;
    __device__ __forceinline__ void operator()(const f32x4 (&acc)[2][2][4][2], const Unit& u, int wr, int wc, int fr, int fq) const {
        asm volatile("" : "+v"(fr), "+v"(fq));
#pragma unroll
        for (int ai = 0; ai < 2; ++ai)
#pragma unroll
            for (int m = 0; m < 4; ++m) {
                const int grow = u.pm * 256 + ai * 128 + wr * 64 + m * 16 + fr; float ss = 0.f;
#pragma unroll
                for (int bj = 0; bj < 2; ++bj) { const size_t off = (size_t)grow * DM + u.pn * 256 + bj * 128 + wc * 32 + fq * 8;
                    const u32x4 xw = *(const u32x4*)(xb + off);
                    f32x4 h0 = acc[ai][bj][m][0], h1 = acc[ai][bj][m][1];
                    h0[0] += bflo(xw.x); h0[1] += bfhi(xw.x); h0[2] += bflo(xw.y); h0[3] += bfhi(xw.y); h1[0] += bflo(xw.z); h1[1] += bfhi(xw.z); h1[2] += bflo(xw.w); h1[3] += bfhi(xw.w);
                    ss += (h0[0] * h0[0] + h0[1] * h0[1]) + (h0[2] * h0[2] + h0[3] * h0[3]) + (h1[0] * h1[0] + h1[1] * h1[1]) + (h1[2] * h1[2] + h1[3] * h1[3]);
                    u32x4 w; w.x = pg8::cvt_pk_bf16(h0[0], h0[1]); w.y = pg8::cvt_pk_bf16(h0[2], h0[3]); w.z = pg8::cvt_pk_bf16(h1[0], h1[1]); w.w = pg8::cvt_pk_bf16(h1[2], h1[3]);
                    *(u32x4*)(H1 + off) = w; }
                ss += __shfl_xor(ss, 16); ss += __shfl_xor(ss, 32);
                if (fq == 0) ss2[(size_t)(u.pn * 4 + wc) * T + grow] = ss;
            }
    }
};
struct EpiG1 { static constexpr bool PERM = true;
    bf16_t* HID; const LAS float* rstdT; const LAS float* wloT; const LAS float* whiT;
    __device__ __forceinline__ void operator()(const f32x4 (&acc)[2][2][4][2], const Unit& u, int wr, int wc, int fr, int fq) const {
        asm volatile("" : "+v"(fr), "+v"(fq));
        const LAS float* wT = (u.pn < 2) ? wloT : whiT;
#pragma unroll
        for (int ai = 0; ai < 2; ++ai)
#pragma unroll
            for (int m = 0; m < 4; ++m) {
                const int rl = ai * 128 + wr * 64 + m * 16 + fr; const float rs = rstdT[u.ui * 256 + rl], w = wT[u.ui * 256 + rl];
                float h[8];
#pragma unroll
                for (int n = 0; n < 2; ++n)
#pragma unroll
                    for (int jj = 0; jj < 4; ++jj) { const float g = acc[ai][0][m][n][jj] * rs, up = acc[ai][1][m][n][jj] * rs;
                        h[n * 4 + jj] = g / (1.0f + __expf(-g)) * up * w; }
                u32x4 o; o.x = pg8::cvt_pk_bf16(h[0], h[1]); o.y = pg8::cvt_pk_bf16(h[2], h[3]); o.z = pg8::cvt_pk_bf16(h[4], h[5]); o.w = pg8::cvt_pk_bf16(h[6], h[7]);
                *(u32x4*)(HID + ((size_t)u.pm * 256 + rl) * 512 + u.pn * 128 + wc * 32 + fq * 8) = o;
            }
    }
};
struct EpiG2 { static constexpr bool PERM = false;
    float* out; const bf16_t* H1; const LAS int* tokT;
    __device__ __forceinline__ void operator()(const f32x4 (&acc)[2][2][4][2], const Unit& u, int wr, int wc, int fr, int fq) const {
        asm volatile("" : "+v"(fr), "+v"(fq));
#pragma unroll
        for (int ai = 0; ai < 2; ++ai)
#pragma unroll
            for (int m = 0; m < 4; ++m) {
                const int rl = ai * 128 + wr * 64 + m * 16 + fr; const int tok = tokT[u.ui * 256 + rl];
                if (rl < u.nv) {
#pragma unroll
                    for (int bj = 0; bj < 2; ++bj)
#pragma unroll
                        for (int n = 0; n < 2; ++n) { const size_t off = (size_t)tok * DM + u.pn * 256 + bj * 128 + wc * 32 + n * 16 + fq * 4;
                            const u32x2 hb = *(const u32x2*)(H1 + off);
                            f32x4 o = acc[ai][bj][m][n]; o[0] += bflo(hb.x); o[1] += bfhi(hb.x); o[2] += bflo(hb.y); o[3] += bfhi(hb.y);
                            *(f32x4*)(out + off) = o; }
                }
            }
    }
};

__device__ __forceinline__ void p2_pool(Frame& F) {
    const int gw = F.vcu * 8 + F.wave, NGW = F.G * 8, lane = F.lane;
    const int g = lane >> 4, w = 2 << g; const float invw = 1.0f / (float)w;
    for (int task = gw; task < T / 16; task += NGW) {
        const int m0 = task * 16, b = m0 >> 11, pos0 = (m0 & 2047) + NMETA;
        const bf16_t* up = F.UB + ((size_t)b * LSEQ + pos0) * 512 + lane * 8;
        float a[8];
#pragma unroll
        for (int j = 0; j < 8; ++j) a[j] = 0.f;
        for (int i = 1; i < w; ++i) { const u32x4 q = *(const u32x4*)(up - (size_t)i * 512);
            a[0] += bflo(q.x); a[1] += bfhi(q.x); a[2] += bflo(q.y); a[3] += bfhi(q.y); a[4] += bflo(q.z); a[5] += bfhi(q.z); a[6] += bflo(q.w); a[7] += bfhi(q.w); }
#pragma unroll 4
        for (int t = 0; t < 16; ++t) {
            const u32x4 nw = *(const u32x4*)(up + (size_t)t * 512);
            a[0] += bflo(nw.x); a[1] += bfhi(nw.x); a[2] += bflo(nw.y); a[3] += bfhi(nw.y); a[4] += bflo(nw.z); a[5] += bfhi(nw.z); a[6] += bflo(nw.w); a[7] += bfhi(nw.w);
            u32x4 o;
            o.x = pk2(a[0] * invw - bflo(nw.x), a[1] * invw - bfhi(nw.x)); o.y = pk2(a[2] * invw - bflo(nw.y), a[3] * invw - bfhi(nw.y));
            o.z = pk2(a[4] * invw - bflo(nw.z), a[5] * invw - bfhi(nw.z)); o.w = pk2(a[6] * invw - bflo(nw.w), a[7] * invw - bfhi(nw.w));
            *(u32x4*)(F.YMIX + (size_t)(m0 + t) * DM + lane * 8) = o;
            const u32x4 od = *(const u32x4*)(up + (long)(t - (w - 1)) * 512);
            a[0] -= bflo(od.x); a[1] -= bfhi(od.x); a[2] -= bflo(od.y); a[3] -= bfhi(od.y); a[4] -= bflo(od.z); a[5] -= bfhi(od.z); a[6] -= bflo(od.w); a[7] -= bfhi(od.w);
        }
    }
}
typedef float f32x16 __attribute__((ext_vector_type(16)));
__device__ __forceinline__ unsigned cvtpk_s(float lo, float hi) { typedef __bf16 bf16x2_t __attribute__((ext_vector_type(2))); f32x2 v = {lo, hi}; bf16x2_t b = __builtin_convertvector(v, bf16x2_t); return __builtin_bit_cast(unsigned, b); }
constexpr int ATT_IMG = 65536, ATT_VOFF = 32768;
struct AttStage { u32x4 k[4]; u32x4 v[4]; };
__device__ __forceinline__ void att_band_load(AttStage& st, const bf16_t* Kb, const bf16_t* Vb, int kl, int tid) {
#pragma unroll
    for (int j = 0; j < 4; ++j) { const int p = tid + 512 * j, key = p >> 3, c = p & 7, slot = key >> 5; int tile = (slot == 0) ? 0 : kl + slot - 1; tile = tile < 0 ? 0 : tile;
        st.k[j] = *(const u32x4*)(Kb + ((size_t)tile * 32 + (key & 31)) * HD + c * 8); }
#pragma unroll
    for (int j = 0; j < 4; ++j) { const int p = tid + 512 * j, d = p >> 5, c = p & 31, slot = c >> 2; int tile = (slot == 0) ? 0 : kl + slot - 1; tile = tile < 0 ? 0 : tile;
        st.v[j] = *(const u32x4*)(Vb + (size_t)d * LP + tile * 32 + (c & 3) * 8); }
}
__device__ __forceinline__ void att_band_store(const AttStage& st, LAS unsigned char* img, int tid) {
#pragma unroll
    for (int j = 0; j < 4; ++j) { const int p = tid + 512 * j, key = p >> 3, c = p & 7; *(LAS u32x4*)(img + key * 128 + ((c ^ (key & 7)) << 4)) = st.k[j]; }
#pragma unroll
    for (int j = 0; j < 4; ++j) { const int p = tid + 512 * j, d = p >> 5, c = p & 31; *(LAS u32x4*)(img + ATT_VOFF + d * 512 + ((c ^ (d & 15)) << 4)) = st.v[j]; }
}
template <int MODE>
__device__ __forceinline__ void attn_tile(f32x16& o0, f32x16& o1, float& l, const bf16x8 (&qf)[4], const LAS unsigned char* img, int slot, int r, int h, float cinit, int x, int thr, bool ex) {
    f32x16 s;
#pragma unroll
    for (int i = 0; i < 16; ++i) s[i] = cinit;
    const int key = slot * 32 + r;
    const LAS unsigned char* kp = img + key * 128;
#pragma unroll
    for (int ks = 0; ks < 4; ++ks) { const bf16x8 kf = *(const LAS bf16x8*)(kp + (((2 * ks + h) ^ (key & 7)) << 4)); s = __builtin_amdgcn_mfma_f32_32x32x16_bf16(kf, qf[ks], s, 0, 0, 0); }
    float e[16];
#pragma unroll
    for (int i = 0; i < 16; ++i) {
        const int c = (i & 3) + 8 * (i >> 2);
        float v = __builtin_amdgcn_exp2f(s[i]);
        if (MODE == 1) { bool vis = (x - c) < thr; if (i < 8) vis = vis || ex; v = vis ? v : 0.f; }
        if (MODE == 2) { const bool vis = (x - c) >= thr; v = vis ? v : 0.f; }
        if (MODE == 3) { if (i >= 8) v = 0.f; }
        e[i] = v; l += v;
    }
    bf16x8 pf0, pf1;
    { u32x4 w0, w1;
      w0.x = cvtpk_s(e[0], e[1]); w0.y = cvtpk_s(e[2], e[3]); w0.z = cvtpk_s(e[4], e[5]); w0.w = cvtpk_s(e[6], e[7]);
      w1.x = cvtpk_s(e[8], e[9]); w1.y = cvtpk_s(e[10], e[11]); w1.z = cvtpk_s(e[12], e[13]); w1.w = cvtpk_s(e[14], e[15]);
      pf0 = __builtin_bit_cast(bf16x8, w0); pf1 = __builtin_bit_cast(bf16x8, w1); }
    const LAS unsigned char* vp = img + ATT_VOFF + r * 512; const int sw = r & 15;
    { const bf16x8 v00 = *(const LAS bf16x8*)(vp + (((4 * slot + h) ^ sw) << 4)), v10 = *(const LAS bf16x8*)(vp + 32 * 512 + (((4 * slot + h) ^ sw) << 4));
      o0 = __builtin_amdgcn_mfma_f32_32x32x16_bf16(v00, pf0, o0, 0, 0, 0); o1 = __builtin_amdgcn_mfma_f32_32x32x16_bf16(v10, pf0, o1, 0, 0, 0); }
    if (MODE != 3) { const bf16x8 v01 = *(const LAS bf16x8*)(vp + (((4 * slot + 2 + h) ^ sw) << 4)), v11 = *(const LAS bf16x8*)(vp + 32 * 512 + (((4 * slot + 2 + h) ^ sw) << 4));
      o0 = __builtin_amdgcn_mfma_f32_32x32x16_bf16(v01, pf1, o0, 0, 0, 0); o1 = __builtin_amdgcn_mfma_f32_32x32x16_bf16(v11, pf1, o1, 0, 0, 0); }
}
__device__ __forceinline__ void p2_attn(Frame& F) {
    const int lane = F.lane, wave = F.wave, tid = F.tid, r = lane & 31, h = lane >> 5;
    const float gq = wave_max(fabsf(F.qg[lane])), gk = wave_max(fabsf(F.kg[lane]));
    const float cb = 8.0f * LOG2E * gq * gk * 1.01f;
    const int x = r - 4 * h;
    const float NEG = -1.0e30f;
    const int NT2 = NB * NKVH * 32;
    int cur = 0;
    AttStage st;
    if (F.vcu < NT2) { const int bt = F.vcu, b = bt >> 6, kvh = (bt >> 5) & 1, kl = 2 * (bt & 31) - 4;
        att_band_load(st, F.KB + ((size_t)b * 2 + kvh) * LP * HD, F.VB + ((size_t)b * 2 + kvh) * HD * LP, kl, tid);
        att_band_store(st, F.lds, tid); }
    __syncthreads();
    for (int bt = F.vcu; bt < NT2; bt += F.G) {
        const int b = bt >> 6, kvh = (bt >> 5) & 1, a = wave >> 2, qt = 2 * (bt & 31) + a, hq = wave & 3, head = kvh * 4 + hq;
        const int btn = bt + F.G; const bool has_next = btn < NT2;
        if (has_next) { const int bn = btn >> 6, kvn = (btn >> 5) & 1, kln = 2 * (btn & 31) - 4;
            att_band_load(st, F.KB + ((size_t)bn * 2 + kvn) * LP * HD, F.VB + ((size_t)bn * 2 + kvn) * HD * LP, kln, tid); }
        const LAS unsigned char* img = F.lds + cur * ATT_IMG;
        const int m0 = b * SEQ + 32 * qt;
        const bf16_t* qp = F.QB + (size_t)(m0 + r) * 512 + head * HD + 8 * h;
        bf16x8 qf[4];
#pragma unroll
        for (int ks = 0; ks < 4; ++ks) qf[ks] = *(const bf16x8*)(qp + 16 * ks);
        f32x16 o0, o1;
#pragma unroll
        for (int i = 0; i < 16; ++i) { o0[i] = 0.f; o1[i] = 0.f; }
        float l = 0.f;
        attn_tile<3>(o0, o1, l, qf, img, 0, r, h, (qt >= 5) ? -cb : NEG, x, 0, false);
        attn_tile<1>(o0, o1, l, qf, img, 1 + a, r, h, (qt - 4 >= 0) ? -cb : NEG, x, -16, qt - 4 == 0);
        attn_tile<1>(o0, o1, l, qf, img, 2 + a, r, h, (qt - 3 >= 0) ? -cb : NEG, x, 16, qt - 3 == 0);
        attn_tile<0>(o0, o1, l, qf, img, 3 + a, r, h, (qt - 2 >= 0) ? -cb : NEG, x, 0, false);
        attn_tile<0>(o0, o1, l, qf, img, 4 + a, r, h, (qt - 1 >= 0) ? -cb : NEG, x, 0, false);
        attn_tile<2>(o0, o1, l, qf, img, 5 + a, r, h, -cb, x, -16, false);
        attn_tile<2>(o0, o1, l, qf, img, 6 + a, r, h, -cb, x, 16, false);
        l += __shfl_xor(l, 32);
        l += __builtin_amdgcn_exp2f(F.sinks[head] * LOG2E - cb);
        const float inv = 1.0f / l;
        bf16_t* op = F.YMIX + (size_t)(m0 + r) * DM + 512 + head * HD + 4 * h;
#pragma unroll
        for (int g4 = 0; g4 < 4; ++g4) {
            u32x2 w0, w1;
            w0.x = cvtpk_s(o0[4 * g4] * inv, o0[4 * g4 + 1] * inv); w0.y = cvtpk_s(o0[4 * g4 + 2] * inv, o0[4 * g4 + 3] * inv);
            w1.x = cvtpk_s(o1[4 * g4] * inv, o1[4 * g4 + 1] * inv); w1.y = cvtpk_s(o1[4 * g4 + 2] * inv, o1[4 * g4 + 3] * inv);
            *(u32x2*)(op + 8 * g4) = w0; *(u32x2*)(op + 32 + 8 * g4) = w1;
        }
        if (has_next) att_band_store(st, F.lds + (cur ^ 1) * ATT_IMG, tid);
        __syncthreads();
        cur ^= 1;
    }
}

__device__ __forceinline__ void p4_route(Frame& F, int dummy) {
    const int lane = F.lane, wave = F.wave, tid = F.tid;
    LAS float* lg = (LAS float*)(F.lds) + wave * 512;
    LAS int* hist = (LAS int*)(F.lds + 32768);
    for (int chunk = F.vcu; chunk < T / 128; chunk += F.G) {
        if (tid < 48) hist[tid] = 0;
        __syncthreads();
        const int tok0 = chunk * 128 + wave * 16;
        f32x4 a0 = {0.f, 0.f, 0.f, 0.f}, a1 = {0.f, 0.f, 0.f, 0.f};
        const bf16_t* hp = F.H1 + (size_t)(tok0 + (lane & 15)) * DM + 8 * (lane >> 4);
        const bf16_t* wp = F.Wr_t + (size_t)(lane & 15) * DM + 8 * (lane >> 4);
#pragma unroll 8
        for (int kk = 0; kk < 32; ++kk) { const bf16x8 a = *(const bf16x8*)(hp + kk * 32), b0 = *(const bf16x8*)(wp + kk * 32), b1 = *(const bf16x8*)(wp + 16 * DM + kk * 32);
            a0 = __builtin_amdgcn_mfma_f32_16x16x32_bf16(a, b0, a0, 0, 0, 0); a1 = __builtin_amdgcn_mfma_f32_16x16x32_bf16(a, b1, a1, 0, 0, 0); }
#pragma unroll
        for (int r = 0; r < 4; ++r) { lg[(4 * (lane >> 4) + r) * 32 + (lane & 15)] = a0[r]; lg[(4 * (lane >> 4) + r) * 32 + 16 + (lane & 15)] = a1[r]; }
        LDS_WAIT(); asm volatile("" ::: "memory");
        int p = 0, rank = 0; float wlo = 0.f, whi = 0.f, rs = 0.f; const int tok = tok0 + lane;
        if (lane < 16) {
            float ss = 0.f;
#pragma unroll
            for (int q = 0; q < 16; ++q) ss += F.ss2[(size_t)q * T + tok];
            rs = 1.0f / sqrtf(ss * (1.0f / DM) + EPS);
            const LAS float* l = lg + lane * 32;
            const float g0 = l[16] * rs, g1 = l[17] * rs, g2 = l[18] * rs, g3 = l[19] * rs;
            int gi = 0; float gm = g0; if (g1 > gm) { gm = g1; gi = 1; } if (g2 > gm) { gm = g2; gi = 2; } if (g3 > gm) { gm = g3; gi = 3; }
            const float gprob = 1.0f / (expf(g0 - gm) + expf(g1 - gm) + expf(g2 - gm) + expf(g3 - gm));
            const float e0 = l[gi * 4 + 0] * rs, e1 = l[gi * 4 + 1] * rs, e2 = l[gi * 4 + 2] * rs, e3 = l[gi * 4 + 3] * rs;
            int i1 = 0; float v1 = e0; if (e1 > v1) { v1 = e1; i1 = 1; } if (e2 > v1) { v1 = e2; i1 = 2; } if (e3 > v1) { v1 = e3; i1 = 3; }
            int i2 = -1; float v2 = -3.0e38f;
            if (i1 != 0 && e0 > v2) { v2 = e0; i2 = 0; } if (i1 != 1 && e1 > v2) { v2 = e1; i2 = 1; } if (i1 != 2 && e2 > v2) { v2 = e2; i2 = 2; } if (i1 != 3 && e3 > v2) { v2 = e3; i2 = 3; }
            const float p1 = 1.0f / (1.0f + expf(v2 - v1)), p2 = 1.0f - p1;
            const float w1 = p1 * gprob, w2 = p2 * gprob;
            const int lo = i1 < i2 ? i1 : i2, hi = i1 < i2 ? i2 : i1;
            wlo = i1 < i2 ? w1 : w2; whi = i1 < i2 ? w2 : w1;
            const int pidx = (lo == 0) ? (hi - 1) : (lo == 1 ? hi + 1 : 5);
            p = gi * 6 + pidx;
            rank = __hip_atomic_fetch_add(&hist[p], 1, __ATOMIC_RELAXED, __HIP_MEMORY_SCOPE_WORKGROUP);
        }
        __syncthreads();
        if (tid < NPAIR) hist[24 + tid] = (int)atomicAdd(F.ctl + CW_CNT + dummy * 32 + tid, (unsigned)hist[tid]);
        __syncthreads();
        if (lane < 16) { const int slot = hist[24 + p] + rank; int* lp = dummy ? (int*)F.HID : F.list; float* r2 = dummy ? (float*)F.HID + 2 * MiB : F.rstd2; float* wl = dummy ? (float*)F.HID + 3 * MiB : F.wlo; float* wh = dummy ? (float*)F.HID + 4 * MiB : F.whi;
            lp[(size_t)p * T + slot] = tok; r2[tok] = rs; wl[tok] = wlo; wh[tok] = whi; }
        __syncthreads();
    }
}
__device__ __forceinline__ void moe_tables(Frame& F) {
    LAS int* tokT = (LAS int*)(F.lds + TAB_TOK); LAS float* rstdT = (LAS float*)(F.lds + TAB_RSTD); LAS float* wloT = (LAS float*)(F.lds + TAB_WLO); LAS float* whiT = (LAS float*)(F.lds + TAB_WHI);
    LAS int* hdr = (LAS int*)(F.lds + TAB_HDR); LAS int* pre = hdr + 64;
    const int tid = F.tid;
    if (tid < NPAIR) pre[32 + tid] = (int)__hip_atomic_load(F.ctl + CW_CNT + tid, __ATOMIC_RELAXED, __HIP_MEMORY_SCOPE_AGENT);
    __syncthreads();
    if (tid == 0) { int s = 0; for (int p = 0; p < NPAIR; ++p) { pre[p] = s; s += (pre[32 + p] + 255) >> 8; } pre[NPAIR] = s; }
    __syncthreads();
    const int NT = pre[NPAIR];
    int nu = 0;
    for (int ui = 0; ui < MAXU; ++ui) {
        const int L = ui * F.G + F.vcu; if (L >= 4 * NT) break;
        const int rt = L >> 2, j = L & 3; int p = 0;
        for (int q = 0; q < NPAIR; ++q) if (pre[q] <= rt && rt < pre[q + 1]) p = q;
        const int t = rt - pre[p], cntp = pre[32 + p]; const int nv = (cntp - 256 * t) < 256 ? (cntp - 256 * t) : 256;
        const int g = p / 6, pi = p % 6; const int lo = (pi < 3) ? 0 : (pi < 5 ? 1 : 2); const int hi = (pi < 3) ? pi + 1 : (pi < 5 ? pi - 1 : 3);
        if (tid == 0) { hdr[ui * 8 + 0] = rt; hdr[ui * 8 + 1] = j; hdr[ui * 8 + 2] = g * 4 + lo; hdr[ui * 8 + 3] = g * 4 + hi; hdr[ui * 8 + 4] = nv; }
        if (tid < 256) { const int r = tid < nv ? tid : 0; const int tok = F.list[(size_t)p * T + 256 * t + r];
            tokT[ui * 256 + tid] = tok; rstdT[ui * 256 + tid] = F.rstd2[tok]; wloT[ui * 256 + tid] = tid < nv ? F.wlo[tok] : 0.f; whiT[ui * 256 + tid] = tid < nv ? F.whi[tok] : 0.f; }
        ++nu;
    }
    if (tid == 0) hdr[MAXU * 8] = nu;
    __syncthreads();
}

struct Args { const float* in[16]; float* out; unsigned char* ws; int ph_lo, ph_hi; int reps[10]; };
constexpr int N_LAUNCHES = MK_N_LAUNCHES;
constexpr int PER_PHASE = 7;

__global__ void __launch_bounds__(512, 2) hymba_fwd(Args args) {
    extern __shared__ __attribute__((aligned(16))) unsigned char lds[];
    Frame F;
    F.lds = (LAS unsigned char*)lds;
    F.MISC = (volatile LAS unsigned*)(F.lds + MISC_OFF);
    F.tid = threadIdx.x; F.lane = F.tid & 63; F.wave = __builtin_amdgcn_readfirstlane(F.tid >> 6);
    F.G = gridDim.x; { const int bx = blockIdx.x; F.vcu = (F.G % 8 == 0) ? (bx % 8) * (F.G / 8) + bx / 8 : bx; }
    unsigned char* ws = args.ws;
    F.ctl = (unsigned*)(ws + WS_CTL);
    F.x = args.in[0]; F.meta = args.in[1]; F.g1 = args.in[2]; F.win = args.in[3]; F.wpool = args.in[4]; F.pscale = args.in[5]; F.qg = args.in[6]; F.kg = args.in[7];
    F.sinks = args.in[8]; F.wout = args.in[9]; F.g2 = args.in[10]; F.wgr = args.in[11]; F.wer = args.in[12]; F.wgate = args.in[13]; F.wup = args.in[14]; F.wdown = args.in[15];
    F.out = args.out;
    F.Win_t = (bf16_t*)(ws + WS_WIN); F.Wout_t = (bf16_t*)(ws + WS_WOUT); F.Wgu_t = (bf16_t*)(ws + WS_WGU); F.Wd_t = (bf16_t*)(ws + WS_WD); F.Wr_t = (bf16_t*)(ws + WS_WR);
    F.XB = (bf16_t*)(ws + WS_XB); F.UB = (bf16_t*)(ws + WS_U); F.QB = (bf16_t*)(ws + WS_Q); F.KB = (bf16_t*)(ws + WS_K); F.VB = (bf16_t*)(ws + WS_V);
    F.YMIX = (bf16_t*)(ws + WS_YMIX); F.H1 = (bf16_t*)(ws + WS_H1); F.HID = (bf16_t*)(ws + WS_HID);
    F.rope = (float*)(ws + WS_ROPE); F.rstd1 = (float*)(ws + WS_RSTD1); F.rstd2 = (float*)(ws + WS_RSTD2); F.wlo = (float*)(ws + WS_WLO); F.whi = (float*)(ws + WS_WHI); F.ss2 = (float*)(ws + WS_SS2);
    F.list = (int*)(ws + WS_LIST);
    for (int u = F.tid; u < (LDS_BYTES - TAB_HDR) / 4; u += 512) ((LAS unsigned*)(F.lds + TAB_HDR))[u] = 0u;
    __syncthreads();
    XcdBarrier bar; bar.bar = (unsigned*)(F.ctl + CW_BAR); bar.x = 0; bar.st = nullptr;
    if (N_LAUNCHES == 1) bar = xcd_barrier_post((unsigned*)(F.ctl + CW_BAR), F.MISC + 8);
    const int lo = args.ph_lo, hi = args.ph_hi;
#ifndef PHASE_MASK
#define PHASE_MASK 0x7f
#endif
#define IN(k) (((PHASE_MASK >> (k)) & 1) && lo <= (k) && (k) < hi)
#define BOTH(k) (IN(k) && IN((k) + 1))
#define GRID_BAR() do { if (N_LAUNCHES == 1) { for (int rb_ = 0; rb_ < NBAR_; ++rb_) xcd_barrier(bar); } } while (0)
#ifndef REPEAT_MASK
#define REPEAT_MASK 0
#endif
#if REPEAT_MASK
#define REP(k) for (int rep_ = 0; rep_ < args.reps[k]; ++rep_)
#define REPI rep_
#define NBAR_ args.reps[8]
#else
#define REP(k)
#define REPI 0
#define NBAR_ 1
#endif

    if (IN(0)) { REP(0) { p0_prologue(F); if (N_LAUNCHES != 1) late_weights(F, F.vcu * 8 + F.wave, F.G * 8); } if (BOTH(0)) GRID_BAR(); }

    if (IN(1)) {
        ProbLinear P{F.XB, F.Win_t, DM, DM, DM}; SchedP1 S{F.G, F.vcu};
        EpiP1 E{F.rstd1, F.rope, F.qg, F.kg, F.UB, F.QB, F.KB, F.VB};
        REP(1) { pg8::gemm_phase(F.lds, P, S, E); }
        if (N_LAUNCHES == 1) { const int nfull = 643 % F.G;
            if (F.vcu >= nfull) late_weights(F, (F.vcu - nfull) * 8 + F.wave, (F.G - nfull) * 8); }
        if (BOTH(1)) GRID_BAR();
    }
    if (IN(2)) { REP(2) { p2_pool(F); } REP(7) { p2_attn(F); } if (BOTH(2)) GRID_BAR(); }
    if (IN(3)) {
        ProbLinear P{F.YMIX, F.Wout_t, DM, DM, DM}; SchedP3 S{F.G, F.vcu};
        EpiP3 E{F.XB, F.H1, F.ss2};
        REP(3) { pg8::gemm_phase(F.lds, P, S, E); }
        if (BOTH(3)) GRID_BAR();
    }
    if (IN(4)) { REP(4) { p4_route(F, REPI); } if (BOTH(4)) GRID_BAR(); }
    if (IN(5)) {
        moe_tables(F);
        ProbG1 P{F.H1, F.Wgu_t, (const LAS int*)(F.lds + TAB_TOK), DM, DM, DM}; SchedMoe S{(const LAS int*)(F.lds + TAB_HDR)};
        EpiG1 E{F.HID, (const LAS float*)(F.lds + TAB_RSTD), (const LAS float*)(F.lds + TAB_WLO), (const LAS float*)(F.lds + TAB_WHI)};
        REP(5) { pg8::gemm_phase(F.lds, P, S, E); }
        if (BOTH(5)) GRID_BAR();
    }
    if (IN(6)) {
        if (!IN(5)) moe_tables(F);
        ProbG2 P{F.HID, F.Wd_t, 512, 512, DEXP}; SchedMoe S{(const LAS int*)(F.lds + TAB_HDR)};
        EpiG2 E{F.out, F.H1, (const LAS int*)(F.lds + TAB_TOK)};
        REP(6) { pg8::gemm_phase(F.lds, P, S, E); }
    }
#undef IN
#undef BOTH
}

extern "C" void kernel_launch(void* const* d_in, const int* in_sizes, int n_in, void* d_out, int out_size, void* d_ws, size_t ws_size, hipStream_t stream) {
    static int grid = 0;
    if (grid == 0) {
        if (n_in != 16 || in_sizes[0] != T * DM || out_size != T * DM || ws_size < WS_END) { fprintf(stderr, "kernel_launch: unexpected shapes (n_in %d, in0 %d, out %d, ws %zu)\n", n_in, n_in > 0 ? in_sizes[0] : -1, out_size, ws_size); grid = -1; return; }
        int dev = 0, cus = 0, per_cu = 0;
        if (hipGetDevice(&dev) != hipSuccess || hipDeviceGetAttribute(&cus, hipDeviceAttributeMultiprocessorCount, dev) != hipSuccess) { grid = -1; return; }
        if (hipFuncSetAttribute((const void*)hymba_fwd, hipFuncAttributeMaxDynamicSharedMemorySize, LDS_BYTES) != hipSuccess) { fprintf(stderr, "kernel_launch: hipFuncSetAttribute failed\n"); grid = -1; return; }
        if (hipOccupancyMaxActiveBlocksPerMultiprocessor(&per_cu, (const void*)hymba_fwd, 512, LDS_BYTES) != hipSuccess || per_cu < 1)
            fprintf(stderr, "kernel_launch: occupancy query reports %d workgroups per CU\n", per_cu);
        (void)hipGetLastError();
        grid = cus;
    }
    if (grid < 0) return;
    if (hipMemsetAsync((char*)d_ws + WS_CTL, 0, CTL_ZERO_BYTES, stream) != hipSuccess) { fprintf(stderr, "kernel_launch: memset failed\n"); return; }
    Args a{};
    for (int i = 0; i < 16; ++i) a.in[i] = (const float*)d_in[i];
    a.out = (float*)d_out; a.ws = (unsigned char*)d_ws;
    for (int i = 0; i < 10; ++i) a.reps[i] = ((REPEAT_MASK >> i) & 1) ? 2 : 1;
    for (int li = 0; li < N_LAUNCHES; ++li) {
        a.ph_lo = (N_LAUNCHES == PER_PHASE) ? li : 0; a.ph_hi = (N_LAUNCHES == PER_PHASE) ? li + 1 : PER_PHASE;
        hipLaunchKernelGGL(hymba_fwd, dim3(grid), dim3(512), LDS_BYTES, stream, a);
        const hipError_t le = hipPeekAtLastError();
        if (le != hipSuccess) { fprintf(stderr, "kernel_launch: launch %d failed: %s\n", li, hipGetErrorName(le)); break; }
    }
}
```

```cpp
#include <hip/hip_runtime.h>
#include <cstdio>
#include <cstdint>

#ifndef MK_N_LAUNCHES
#define MK_N_LAUNCHES 1
#endif

#define LAS __attribute__((address_space(3)))
#define GAS __attribute__((address_space(1)))
typedef unsigned short bf16_t;
typedef short bf16x8 __attribute__((ext_vector_type(8)));
typedef float f32x4 __attribute__((ext_vector_type(4)));
typedef float f32x2 __attribute__((ext_vector_type(2)));
typedef unsigned u32x4 __attribute__((ext_vector_type(4)));
typedef unsigned u32x2 __attribute__((ext_vector_type(2)));

constexpr int DM = 1024, NB = 16, SEQ = 2048, NMETA = 16, LSEQ = SEQ + NMETA, LP = 2080;
constexpr int T = NB * SEQ;
constexpr int TM = T + 256;
constexpr int INW = 1280, NHEAD = 8, NKVH = 2, HD = 64, NEXP = 16, DEXP = 256, NPAIR = 24;
constexpr float EPS = 1e-6f;
constexpr float LOG2E = 1.4426950408889634f, QSCALE = 0.125f * LOG2E;
constexpr int MAXU = 4;

constexpr size_t MiB = 1u << 20;
constexpr size_t WS_CTL = 0, CTL_ZERO_BYTES = 1 * MiB;
constexpr size_t WS_WIN = 2 * MiB;
constexpr size_t WS_WOUT = 5 * MiB;
constexpr size_t WS_WGU = 8 * MiB;
constexpr size_t WS_WD = 24 * MiB;
constexpr size_t WS_WR = 32 * MiB;
constexpr size_t WS_ROPE = 33 * MiB;
constexpr size_t WS_RSTD1 = 34 * MiB;
constexpr size_t WS_RSTD2 = 35 * MiB;
constexpr size_t WS_WLO = 36 * MiB, WS_WHI = 37 * MiB;
constexpr size_t WS_SS2 = 38 * MiB;
constexpr size_t WS_LIST = 40 * MiB;
constexpr size_t WS_K = 44 * MiB;
constexpr size_t WS_V = 53 * MiB;
constexpr size_t WS_XB = 64 * MiB;
constexpr size_t WS_U = 130 * MiB;
constexpr size_t WS_Q = 164 * MiB;
constexpr size_t WS_YMIX = 196 * MiB;
constexpr size_t WS_H1 = 260 * MiB;
constexpr size_t WS_HID = 324 * MiB;
constexpr size_t WS_DUMP = 364 * MiB;
constexpr size_t WS_END = 366 * MiB;
constexpr int CW_CNT = 64;
constexpr int CW_BAR = 4096;

constexpr int RING_BYTES = 131072;
constexpr int TAB_OFF = RING_BYTES;
constexpr int TAB_TOK = TAB_OFF;
constexpr int TAB_RSTD = TAB_TOK + MAXU * 1024;
constexpr int TAB_WLO = TAB_RSTD + MAXU * 1024;
constexpr int TAB_WHI = TAB_WLO + MAXU * 1024;
constexpr int TAB_HDR = TAB_WHI + MAXU * 1024;
constexpr int MISC_OFF = TAB_HDR + 1024;
constexpr int LDS_BYTES = MISC_OFF + 128;
static_assert(LDS_BYTES <= 163840, "LDS map");

#define LDS_WAIT() asm volatile("s_waitcnt lgkmcnt(0)" ::: "memory")
#define VM_WAIT() asm volatile("s_waitcnt vmcnt(0)" ::: "memory")
__device__ __forceinline__ unsigned f2bf(float f) { unsigned u = __builtin_bit_cast(unsigned, f); return (u + 0x7fffu + ((u >> 16) & 1u)) >> 16; }
__device__ __forceinline__ unsigned pk2(float lo, float hi) { return f2bf(lo) | (f2bf(hi) << 16); }
__device__ __forceinline__ float bflo(unsigned w) { return __builtin_bit_cast(float, w << 16); }
__device__ __forceinline__ float bfhi(unsigned w) { return __builtin_bit_cast(float, w & 0xffff0000u); }
__device__ __forceinline__ float bf1(bf16_t h) { return __builtin_bit_cast(float, (unsigned)h << 16); }
__device__ __forceinline__ float wave_sum(float v) {
#pragma unroll
    for (int o = 1; o < 64; o <<= 1) v += __shfl_xor(v, o);
    return v;
}
__device__ __forceinline__ float wave_max(float v) {
#pragma unroll
    for (int o = 1; o < 64; o <<= 1) v = fmaxf(v, __shfl_xor(v, o));
    return v;
}

namespace pg8 {
constexpr int BM = 256, BK = 64, HALF = 128, HTB = HALF * BK * 2, STAGE_BYTES = 8 * HTB;
__host__ __device__ __forceinline__ int lds_byte(int r, int c) { const int st = (r >> 4) * 2 + (c >> 5), rr = r & 15, cc = c & 31, ob = rr * 64 + cc * 2; return st * 1024 + (ob ^ (((ob >> 9) & 1) << 5)); }
__host__ __device__ __forceinline__ void stage_rc(int b, int& R, int& C) { const int st = b / 1024, sb = b % 1024, swz = sb ^ (((sb >> 9) & 1) << 5); R = (st >> 1) * 16 + swz / 64; C = (st & 1) * 32 + (swz % 64) / 2; }
__host__ __device__ __forceinline__ int perm32(int rho) { const int n = rho >> 4, i = rho & 15; return 8 * (i >> 2) + 4 * n + (i & 3); }

struct Unit { int pm, pn, ui, x0, x1, nv; };
__device__ __forceinline__ unsigned cvt_pk_bf16(float lo, float hi) { unsigned r; asm volatile("v_cvt_pk_bf16_f32 %0, %1, %2" : "=v"(r) : "v"(lo), "v"(hi)); return r; }

template <class Prob, class Epi, class Sched>
__device__ __forceinline__ void gemm_phase(LAS unsigned char* lds, const Prob& P, const Sched& S, const Epi& E) {
    int tid_ = threadIdx.x; asm volatile("" : "+v"(tid_));
    const int tid = tid_, wid = __builtin_amdgcn_readfirstlane(tid >> 6), lane = tid & 63, wr = wid >> 2, wc = wid & 3, fr = lane & 15, fq = lane >> 4;
    const int nt = P.K / BK;
    int Rp[2], Cp[2]; unsigned voffB[2];
#pragma unroll
    for (int i = 0; i < 2; ++i) { stage_rc(tid * 16 + i * 8192, Rp[i], Cp[i]); const int Rb = Epi::PERM ? ((Rp[i] & ~31) + perm32(Rp[i] & 31)) : Rp[i];
        voffB[i] = (unsigned)(Rb * P.ldb + Cp[i]) * 2u; }
    const size_t kstep = (size_t)(BK * 2);
    const size_t hstepB = (size_t)HALF * P.ldb * 2;
    const unsigned ldsw = (unsigned)wid * 1024u;
    const int aoff = lds_byte(wr * 64 + fr, fq * 8), boff = lds_byte(wc * 32 + fr, fq * 8);
#define PG8_SA(b, h) (((b) * 2 + (h)) * HTB)
#define PG8_SB(b, h) ((4 + (b) * 2 + (h)) * HTB)
#define PG8_STAGE(bufoff, gbase, voff) do { _Pragma("unroll") for (int _i = 0; _i < 2; ++_i) \
        __builtin_amdgcn_global_load_lds((const unsigned*)((const char*)(gbase) + (voff)[_i]), (LAS unsigned*)(lds + (bufoff) + ldsw + _i * 8192), 16, 0, 0); } while (0)
#define PG8_LDA(dst, b, h) do { _Pragma("unroll") for (int m = 0; m < 4; ++m) _Pragma("unroll") for (int k = 0; k < 2; ++k) dst[m][k] = *(const LAS bf16x8*)(lds + PG8_SA(b, h) + aoff + m * 2048 + k * 1024); } while (0)
#define PG8_LDB(dst, b, h) do { _Pragma("unroll") for (int n = 0; n < 2; ++n) _Pragma("unroll") for (int k = 0; k < 2; ++k) dst[n][k] = *(const LAS bf16x8*)(lds + PG8_SB(b, h) + boff + n * 2048 + k * 1024); } while (0)
#define PG8_MMA(ai, bj, At, Bt) do { __builtin_amdgcn_s_setprio(1); _Pragma("unroll") for (int m = 0; m < 4; ++m) _Pragma("unroll") for (int n = 0; n < 2; ++n) _Pragma("unroll") for (int k = 0; k < 2; ++k) \
        acc[ai][bj][m][n] = __builtin_amdgcn_mfma_f32_16x16x32_bf16(Bt[n][k], At[m][k], acc[ai][bj][m][n], 0, 0, 0); __builtin_amdgcn_s_setprio(0); } while (0)
#define PG8_WAIT_V(n) asm volatile("s_waitcnt vmcnt(" #n ")" ::: "memory")
#define PG8_WAIT_L(n) asm volatile("s_waitcnt lgkmcnt(" #n ")" ::: "memory")
#define PG8_BAR __builtin_amdgcn_s_barrier()
#define PG8_SCHED __builtin_amdgcn_sched_barrier(0)
    Unit cur, nxt; int ui = 0;
    if (!S.next(0, cur)) return;
    f32x4 acc[2][2][4][2];
#pragma unroll
    for (int a = 0; a < 2; ++a)
#pragma unroll
        for (int b = 0; b < 2; ++b)
#pragma unroll
            for (int m = 0; m < 4; ++m)
#pragma unroll
                for (int n = 0; n < 2; ++n) acc[a][b][m][n] = (f32x4){0.f, 0.f, 0.f, 0.f};
    bf16x8 At[4][2], B0[2][2], B1[2][2];
    unsigned voC[2][2], voN[2][2];
    P.a_voff(cur, Rp, Cp, voC);
    const char* cA = P.a_base(cur);
    {
        const char* b0 = P.b_tile(cur, 0); const char* b1 = P.b_tile(cur, 1);
        PG8_STAGE(PG8_SB(0, 0), b0, voffB); PG8_STAGE(PG8_SB(0, 1), b0 + hstepB, voffB); PG8_STAGE(PG8_SA(0, 0), cA, voC[0]); PG8_STAGE(PG8_SA(0, 1), cA, voC[1]);
        if (wr == 1) PG8_BAR;
        PG8_WAIT_V(2); PG8_BAR;
        PG8_STAGE(PG8_SB(1, 0), b1, voffB); PG8_STAGE(PG8_SA(1, 0), cA + kstep, voC[0]); PG8_STAGE(PG8_SB(1, 1), b1 + hstepB, voffB);
        PG8_WAIT_V(6); PG8_BAR;
    }
    for (;;) {
        const bool has_next = S.next(ui + 1, nxt);
        if (!has_next) nxt = cur;
        if constexpr (Prob::GATHER) P.a_voff(nxt, Rp, Cp, voN);
        const char* nA = P.a_base(nxt);
#pragma clang loop unroll(disable)
        for (int t = 0; t < nt; t += 2) {
            const bool last = (t == nt - 2);
            const char* a1 = cA + (size_t)(t + 1) * kstep;
            const char* a2 = last ? nA : cA + (size_t)(t + 2) * kstep;
            const char* a3 = a2 + kstep;
            const char* b2 = last ? P.b_tile(nxt, 0) : P.b_tile(cur, t + 2);
            const char* b3 = last ? P.b_tile(nxt, 1) : P.b_tile(cur, t + 3);
            unsigned v2[2][2];
#pragma unroll
            for (int h = 0; h < 2; ++h)
#pragma unroll
                for (int i = 0; i < 2; ++i) { if constexpr (Prob::GATHER) v2[h][i] = last ? voN[h][i] : voC[h][i]; else v2[h][i] = voC[h][i]; }
            PG8_LDB(B0, 0, 0); PG8_LDB(B1, 0, 1); PG8_SCHED; PG8_LDA(At, 0, 0); PG8_STAGE(PG8_SA(1, 1), a1, voC[1]);
            PG8_WAIT_V(8); PG8_WAIT_L(0); PG8_BAR; PG8_MMA(0, 0, At, B0); PG8_MMA(0, 1, At, B1); PG8_BAR; PG8_SCHED;
            PG8_LDA(At, 0, 1); PG8_STAGE(PG8_SB(0, 0), b2, voffB); PG8_STAGE(PG8_SB(0, 1), b2 + hstepB, voffB); PG8_STAGE(PG8_SA(0, 0), a2, v2[0]);
            PG8_WAIT_V(8); PG8_WAIT_L(0); PG8_BAR; PG8_MMA(1, 0, At, B0); PG8_MMA(1, 1, At, B1); PG8_BAR; PG8_SCHED;
            PG8_LDB(B0, 1, 0); PG8_LDB(B1, 1, 1); PG8_SCHED; PG8_LDA(At, 1, 0); PG8_STAGE(PG8_SA(0, 1), a2, v2[1]);
            PG8_WAIT_V(8); PG8_WAIT_L(0); PG8_BAR; PG8_MMA(0, 0, At, B0); PG8_MMA(0, 1, At, B1); PG8_BAR; PG8_SCHED;
            PG8_LDA(At, 1, 1); PG8_STAGE(PG8_SB(1, 0), b3, voffB); PG8_STAGE(PG8_SB(1, 1), b3 + hstepB, voffB); PG8_STAGE(PG8_SA(1, 0), a3, v2[0]);
            PG8_WAIT_V(8); PG8_WAIT_L(0); PG8_BAR; PG8_MMA(1, 0, At, B0); PG8_MMA(1, 1, At, B1); PG8_BAR; PG8_SCHED;
        }
        if (wr == 0) PG8_BAR;
        E(acc, cur, wr, wc, fr, fq);
        if (!has_next) break;
#pragma unroll
        for (int a = 0; a < 2; ++a)
#pragma unroll
            for (int b = 0; b < 2; ++b)
#pragma unroll
                for (int m = 0; m < 4; ++m)
#pragma unroll
                    for (int n = 0; n < 2; ++n) acc[a][b][m][n] = (f32x4){0.f, 0.f, 0.f, 0.f};
        cur = nxt; cA = nA; ++ui;
#pragma unroll
        for (int h = 0; h < 2; ++h)
#pragma unroll
            for (int i = 0; i < 2; ++i) { if constexpr (Prob::GATHER) voC[h][i] = voN[h][i]; }
        if (wr == 1) PG8_BAR;
    }
    PG8_WAIT_V(0);
    PG8_BAR;
#undef PG8_SA
#undef PG8_SB
#undef PG8_STAGE
#undef PG8_LDA
#undef PG8_LDB
#undef PG8_MMA
#undef PG8_WAIT_V
#undef PG8_WAIT_L
#undef PG8_BAR
#undef PG8_SCHED
}
}
using pg8::Unit;

typedef GAS unsigned gu32;
#define XB_TMO      128
#define XB_XCNT(j)  (256  + 64 * (j))
#define XB_XSUB(j)  (1280 + 64 * (j))
#define XB_XGEN(j)  (2304 + 64 * (j))
#define XB_TOP      3328
#define XB_TOPGEN   3392
#define XCD_BAR_WORDS 3456
#define XB_SPIN_CAP (1u << 18)
__device__ __forceinline__ unsigned xb_ld(unsigned* p)              { return __hip_atomic_load(p, __ATOMIC_RELAXED, __HIP_MEMORY_SCOPE_AGENT); }
__device__ __forceinline__ unsigned xb_add(unsigned* p, unsigned v) { return __hip_atomic_fetch_add(p, v, __ATOMIC_RELAXED, __HIP_MEMORY_SCOPE_AGENT); }
__device__ __forceinline__ unsigned xb_xcc_id() { return (unsigned)__builtin_amdgcn_s_getreg((3 << 11) | 20) & 0xFu; }
#define XB_SPIN(cond, bar) do { unsigned _sp = 0; while (cond) { __builtin_amdgcn_s_sleep(1); \
    if ((++_sp & 255u) == 0u) { if (xb_ld(&(bar)[XB_TMO])) break; if (_sp > XB_SPIN_CAP) { atomicAdd(&(bar)[XB_TMO], 1u); break; } } } } while (0)
struct XcdBarrier { unsigned* bar; unsigned x; volatile LAS unsigned* st; };
__device__ __forceinline__ XcdBarrier xcd_barrier_post(unsigned* bar, volatile LAS unsigned* st) {
    XcdBarrier b; b.bar = bar; b.x = xb_xcc_id(); b.st = st;
    if (threadIdx.x == 0) (void)xb_add(&bar[XB_XCNT(b.x)], 1u);
    return b;
}
__device__ __forceinline__ void xcd_barrier_complete(unsigned* bar, unsigned x, unsigned& nloc, unsigned& nx) {
    const unsigned G = gridDim.x * gridDim.y * gridDim.z;
    unsigned sum, cnt, mine, sp = 0u;
    for (;;) {
        sum = 0u; cnt = 0u; mine = 0u;
#pragma unroll
        for (unsigned j = 0; j < 16; ++j) { const unsigned c = xb_ld(&bar[XB_XCNT(j)]); sum += c; cnt += (c > 0u) ? 1u : 0u; mine = (j == x) ? c : mine; }
        if (sum == G) break;
        __builtin_amdgcn_s_sleep(1);
        if ((++sp & 255u) == 0u) { if (xb_ld(&bar[XB_TMO])) break; if (sp > XB_SPIN_CAP) { atomicAdd(&bar[XB_TMO], 1u); break; } }
    }
    nloc = mine > 0u ? mine : 1u; nx = cnt > 0u ? cnt : 1u;
}
__device__ __forceinline__ void xcd_barrier(const XcdBarrier& b) {
    asm volatile("s_waitcnt vmcnt(0)" ::: "memory");
    __syncthreads();
    if (threadIdx.x == 0) {
        unsigned* bar = b.bar;
        __builtin_amdgcn_s_waitcnt(0);
        unsigned nloc = b.st[0], nx = b.st[1];
        if (nloc == 0u) { xcd_barrier_complete(bar, b.x, nloc, nx); b.st[0] = nloc; b.st[1] = nx; }
        const unsigned old = xb_add(&bar[XB_XSUB(b.x)], 1u);
        const unsigned gen = old / nloc;
        if (old + 1u == (gen + 1u) * nloc) {
            __builtin_amdgcn_fence(__ATOMIC_RELEASE, "agent");
            asm volatile("s_waitcnt vmcnt(0)" ::: "memory");
            const unsigned og = xb_add(&bar[XB_TOP], 1u);
            const unsigned tg = og / nx;
            if (og + 1u == (tg + 1u) * nx) xb_add(&bar[XB_TOPGEN], 1u);
            else XB_SPIN(xb_ld(&bar[XB_TOPGEN]) == tg, bar);
            __builtin_amdgcn_fence(__ATOMIC_ACQUIRE, "agent");
            xb_add(&bar[XB_XGEN(b.x)], 1u);
            asm volatile("s_waitcnt vmcnt(0)" ::: "memory");
        } else {
            XB_SPIN(xb_ld(&bar[XB_XGEN(b.x)]) == gen, bar);
            __builtin_amdgcn_fence(__ATOMIC_ACQUIRE, "agent");
            asm volatile("s_waitcnt vmcnt(0)" ::: "memory");
        }
    }
    __syncthreads();
}

struct Frame {
    LAS unsigned char* lds;
    volatile LAS unsigned* MISC;
    unsigned* ctl;
    int tid, lane, wave, vcu, G;
    const float *x, *meta, *g1, *win, *wpool, *pscale, *qg, *kg, *sinks, *wout, *g2, *wgr, *wer, *wgate, *wup, *wdown;
    float* out;
    bf16_t *Win_t, *Wout_t, *Wgu_t, *Wd_t, *Wr_t, *XB, *UB, *QB, *KB, *VB, *YMIX, *H1, *HID;
    float *rope, *rstd1, *rstd2, *wlo, *whi, *ss2;
    int* list;
};

__device__ __forceinline__ void transpose_item(const float* W, int ldw, int k0, int n0, const float* scale, bf16_t* dst, int ldd, LAS float* scr, int lane) {
    const int c4 = lane & 7, kr = lane >> 3;
    f32x4 v[8];
#pragma unroll
    for (int i = 0; i < 8; ++i) v[i] = *(const f32x4*)(W + (size_t)(k0 + 8 * i + kr) * ldw + n0 + 4 * c4);
#pragma unroll
    for (int i = 0; i < 8; ++i) { const int kk = 8 * i + kr; f32x4 t = v[i]; if (scale) t = t * scale[k0 + kk];
        LAS float* d = scr + kk * 33 + 4 * c4; d[0] = t[0]; d[1] = t[1]; d[2] = t[2]; d[3] = t[3]; }
    LDS_WAIT(); asm volatile("" ::: "memory");
    const int c = lane & 7;
#pragma unroll
    for (int j = 0; j < 4; ++j) { const int n = (lane >> 3) + 8 * j; const LAS float* s = scr + (8 * c) * 33 + n;
        u32x4 o; o.x = pk2(s[0 * 33], s[1 * 33]); o.y = pk2(s[2 * 33], s[3 * 33]); o.z = pk2(s[4 * 33], s[5 * 33]); o.w = pk2(s[6 * 33], s[7 * 33]);
        *(u32x4*)(dst + (size_t)n * ldd + 8 * c) = o; }
    LDS_WAIT(); asm volatile("" ::: "memory");
}
__device__ __forceinline__ void row_to_bf16(const float* xrow, bf16_t* orow, float* rstd_out, int lane) {
    const f32x4* xr = (const f32x4*)xrow + lane;
    f32x4 v[4]; float s = 0.f;
#pragma unroll
    for (int j = 0; j < 4; ++j) { v[j] = xr[64 * j]; s += (v[j].x * v[j].x + v[j].y * v[j].y) + (v[j].z * v[j].z + v[j].w * v[j].w); }
    s = wave_sum(s);
    u32x2* o8 = (u32x2*)orow + lane;
#pragma unroll
    for (int j = 0; j < 4; ++j) { u32x2 w; w.x = pk2(v[j].x, v[j].y); w.y = pk2(v[j].z, v[j].w); o8[64 * j] = w; }
    if (lane == 0) *rstd_out = 1.0f / sqrtf(s * (1.0f / DM) + EPS);
}

__device__ __forceinline__ void late_weights(Frame& F, int gw, int NGW) {
    LAS float* scr = (LAS float*)(F.lds + F.wave * 16384);
    const int lane = F.lane;
    constexpr int I_GU = 32 * 128, I_D = 16 * 128, I_O = 8 * 32;
    constexpr int NITEMS = I_GU + I_D + I_O;
    for (int it = gw; it < NITEMS; it += NGW) {
        int r = it;
        if (r < I_GU) { const int mat = r / 128, rr = r % 128, kb = rr / 8, fg = rr % 8, e = mat >> 1, isup = mat & 1;
            const float* W = (isup ? F.wup : F.wgate) + (size_t)e * DM * DEXP;
            const int drow = 256 * (fg >> 2) + 128 * isup + 32 * (fg & 3);
            transpose_item(W, DEXP, kb * 64, fg * 32, F.g2, F.Wgu_t + ((size_t)e * 512 + drow) * DM + kb * 64, DM, scr, lane); continue; }
        r -= I_GU;
        if (r < I_D) { const int e = r / 128, rr = r % 128, kb = rr / 32, nb = rr % 32;
            transpose_item(F.wdown + (size_t)e * DEXP * DM, DM, kb * 64, nb * 32, nullptr, F.Wd_t + ((size_t)e * DM + nb * 32) * DEXP + kb * 64, DEXP, scr, lane); continue; }
        r -= I_D;
        { const int kb = r / 32, nb = r % 32;
            transpose_item(F.wout + (size_t)512 * DM, DM, kb * 64, nb * 32, nullptr, F.Wout_t + (size_t)(nb * 32) * DM + 512 + kb * 64, DM, scr, lane); }
    }
    for (int it = gw; it < 1024; it += NGW) {
        const int g = it >> 8, cc = (it >> 4) & 15, nb = it & 15, n = nb * 64 + lane;
        float a[8];
#pragma unroll
        for (int j = 0; j < 8; ++j) a[j] = 0.f;
        const float* wp = F.wpool + ((size_t)g * 128 + cc * 8) * 128;
#pragma unroll 4
        for (int d = 0; d < 128; ++d) {
            const float wo = F.wout[(size_t)(g * 128 + d) * DM + n] * F.pscale[g * 128 + d];
#pragma unroll
            for (int j = 0; j < 8; ++j) a[j] += wp[j * 128 + d] * wo;
        }
        u32x4 o; o.x = pk2(a[0], a[1]); o.y = pk2(a[2], a[3]); o.z = pk2(a[4], a[5]); o.w = pk2(a[6], a[7]);
        *(u32x4*)(F.Wout_t + (size_t)n * DM + g * 128 + cc * 8) = o;
    }
    for (int i = gw * 64 + lane; i < 32 * DM; i += NGW * 64) {
        const int j = i >> 10, k = i & 1023; float v = 0.f;
        if (j < 16) v = F.wer[k * 16 + j] * F.g2[k]; else if (j < 20) v = F.wgr[k * 4 + (j - 16)] * F.g2[k];
        F.Wr_t[i] = (bf16_t)f2bf(v);
    }
}
__device__ __forceinline__ void p0_prologue(Frame& F) {
    LAS float* scr = (LAS float*)(F.lds + F.wave * 16384);
    const int gw = F.vcu * 8 + F.wave, NGW = F.G * 8, lane = F.lane;
    for (int r = gw; r < 16 * 40; r += NGW) {
        const int kb = r / 40, sg = r % 40; int drow;
        if (sg < 16) drow = sg * 32;
        else if (sg < 32) { const int qc = (sg - 16) * 32, head = qc >> 6, half = (qc >> 5) & 1; drow = 256 * (2 + (head >> 2)) + 128 * half + 32 * (head & 3); }
        else { const int kc = (sg - 32) * 32, hh = kc >> 6, half = (kc >> 5) & 1; drow = 1024 + 128 * half + 32 * hh; }
        transpose_item(F.win, INW, kb * 64, sg * 32, F.g1, F.Win_t + (size_t)drow * DM + kb * 64, DM, scr, lane);
    }
    for (int i = gw * 64 + lane; i < LSEQ * 8; i += NGW * 64) {
        const int pos = i >> 3, fi = i & 7;
        double f = 1.0;
        if (fi == 1) f = 0.19392274474868576; if (fi == 2) f = 0.03760603093086393; if (fi == 3) f = 0.007292664737217109; if (fi == 4) f = 0.001414213562373095;
        if (fi == 5) f = 0.0002742481756762073; if (fi == 6) f = 5.318295896944988e-05; if (fi == 7) f = 1.031338537721246e-05;
        const double rev = (double)pos * f * 0.15915494309189535;
        const double fr = rev - __builtin_floor(rev + 0.5);
        const double qd = __builtin_floor(fr * 4.0 + 0.5);
        const double tt = (fr - qd * 0.25) * 6.283185307179586;
        const double t2 = tt * tt;
        const double sn = tt * (1.0 + t2 * (-1.0 / 6 + t2 * (1.0 / 120 + t2 * (-1.0 / 5040 + t2 * (1.0 / 362880 + t2 * (-1.0 / 39916800 + t2 * (1.0 / 6227020800.0)))))));
        const double cs = 1.0 + t2 * (-0.5 + t2 * (1.0 / 24 + t2 * (-1.0 / 720 + t2 * (1.0 / 40320 + t2 * (-1.0 / 3628800 + t2 * (1.0 / 479001600.0))))));
        const int qi = ((int)qd) & 3;
        const double c4 = (qi == 0) ? cs : (qi == 1) ? -sn : (qi == 2) ? -cs : sn;
        const double s4 = (qi == 0) ? sn : (qi == 1) ? cs : (qi == 2) ? -sn : -cs;
        F.rope[2 * i] = (float)c4; F.rope[2 * i + 1] = (float)s4;
    }
    for (int m = gw; m < T; m += 2 * NGW) {
        const int m2 = m + NGW;
        const f32x4* xa = (const f32x4*)(F.x + (size_t)m * DM) + lane; const f32x4* xb = (const f32x4*)(F.x + (size_t)(m2 < T ? m2 : m) * DM) + lane;
        f32x4 va[4], vb[4]; float sa = 0.f, sb = 0.f;
#pragma unroll
        for (int j = 0; j < 4; ++j) { va[j] = xa[64 * j]; vb[j] = xb[64 * j]; }
#pragma unroll
        for (int j = 0; j < 4; ++j) { sa += (va[j].x * va[j].x + va[j].y * va[j].y) + (va[j].z * va[j].z + va[j].w * va[j].w); sb += (vb[j].x * vb[j].x + vb[j].y * vb[j].y) + (vb[j].z * vb[j].z + vb[j].w * vb[j].w); }
        sa = wave_sum(sa); sb = wave_sum(sb);
        u32x2* oa = (u32x2*)(F.XB + (size_t)m * DM) + lane; u32x2* ob = (u32x2*)(F.XB + (size_t)m2 * DM) + lane;
#pragma unroll
        for (int j = 0; j < 4; ++j) { u32x2 w; w.x = pk2(va[j].x, va[j].y); w.y = pk2(va[j].z, va[j].w); oa[64 * j] = w; }
        if (lane == 0) F.rstd1[m] = 1.0f / sqrtf(sa * (1.0f / DM) + EPS);
        if (m2 < T) {
#pragma unroll
            for (int j = 0; j < 4; ++j) { u32x2 w; w.x = pk2(vb[j].x, vb[j].y); w.y = pk2(vb[j].z, vb[j].w); ob[64 * j] = w; }
            if (lane == 0) F.rstd1[m2] = 1.0f / sqrtf(sb * (1.0f / DM) + EPS);
        }
    }
    for (int m = T + gw; m < T + NMETA; m += NGW) row_to_bf16(F.meta + (size_t)(m - T) * DM, F.XB + (size_t)m * DM, F.rstd1 + m, lane);
    for (int i = gw * 64 + lane; i < (256 - NMETA) * DM / 8; i += NGW * 64) ((u32x4*)(F.XB + (size_t)(T + NMETA) * DM))[i] = (u32x4){0u, 0u, 0u, 0u};
    for (int i = gw * 64 + lane; i < 256 - NMETA; i += NGW * 64) F.rstd1[T + NMETA + i] = 0.f;
    for (int i = gw * 64 + lane; i < 32 * 16 * 8; i += NGW * 64) { const int bh = i >> 7, r = (i >> 3) & 15, c = i & 7;
        *(u32x4*)(F.KB + ((size_t)bh * LP + LSEQ + r) * HD + c * 8) = (u32x4){0u, 0u, 0u, 0u}; }
    for (int i = gw * 64 + lane; i < 32 * 64 * 2; i += NGW * 64) { const int row = i >> 1, c = i & 1;
        *(u32x4*)(F.VB + (size_t)row * LP + LSEQ + c * 8) = (u32x4){0u, 0u, 0u, 0u}; }
}

struct SchedP1 { int G, c;
    __device__ __forceinline__ bool next(int i, Unit& u) const { const int L = i * G + c; if (L >= 643) return false;
        if (L < 640) { u.pm = L / 5; u.pn = L % 5; } else { u.pm = 128; u.pn = (L == 642) ? 4 : (L - 640); }
        u.ui = 0; u.x0 = 0; u.x1 = 0; u.nv = 256; return true; } };
struct SchedP3 { int G, c;
    __device__ __forceinline__ bool next(int i, Unit& u) const { const int L = i * G + c; if (L >= 512) return false; u.pm = L >> 2; u.pn = L & 3; u.ui = 0; u.x0 = 0; u.x1 = 0; u.nv = 256; return true; } };
struct SchedMoe { const LAS int* hdr;
    __device__ __forceinline__ bool next(int i, Unit& u) const {
        const int n = __builtin_amdgcn_readfirstlane(hdr[MAXU * 8]); if (i >= n) return false;
        u.pm = __builtin_amdgcn_readfirstlane(hdr[i * 8 + 0]); u.pn = __builtin_amdgcn_readfirstlane(hdr[i * 8 + 1]);
        u.x0 = __builtin_amdgcn_readfirstlane(hdr[i * 8 + 2]); u.x1 = __builtin_amdgcn_readfirstlane(hdr[i * 8 + 3]);
        u.nv = __builtin_amdgcn_readfirstlane(hdr[i * 8 + 4]); u.ui = i; return true; } };

struct ProbLinear { static constexpr bool GATHER = false; const bf16_t* A; const bf16_t* Bt; int K, lda, ldb;
    __device__ __forceinline__ const char* a_base(const Unit& u) const { return (const char*)A + (size_t)u.pm * 256 * lda * 2; }
    __device__ __forceinline__ void a_voff(const Unit&, const int (&Rp)[2], const int (&Cp)[2], unsigned (&vo)[2][2]) const {
#pragma unroll
        for (int h = 0; h < 2; ++h)
#pragma unroll
            for (int i = 0; i < 2; ++i) vo[h][i] = (unsigned)((h * 128 + Rp[i]) * lda + Cp[i]) * 2u; }
    __device__ __forceinline__ const char* b_tile(const Unit& u, int kt) const { return (const char*)Bt + (size_t)u.pn * 256 * ldb * 2 + (size_t)kt * 128; } };
struct ProbG1 { static constexpr bool GATHER = true; const bf16_t* A; const bf16_t* Wgu; const LAS int* tokT; int K, lda, ldb;
    __device__ __forceinline__ const char* a_base(const Unit&) const { return (const char*)A; }
    __device__ __forceinline__ void a_voff(const Unit& u, const int (&Rp)[2], const int (&Cp)[2], unsigned (&vo)[2][2]) const {
#pragma unroll
        for (int h = 0; h < 2; ++h)
#pragma unroll
            for (int i = 0; i < 2; ++i) { const int tok = tokT[u.ui * 256 + h * 128 + Rp[i]]; vo[h][i] = (unsigned)(tok * DM + Cp[i]) * 2u; } }
    __device__ __forceinline__ const char* b_tile(const Unit& u, int kt) const { const int e = (u.pn < 2) ? u.x0 : u.x1;
        return (const char*)Wgu + ((size_t)e * 512 + (u.pn & 1) * 256) * DM * 2 + (size_t)kt * 128; } };
struct ProbG2 { static constexpr bool GATHER = false; const bf16_t* A; const bf16_t* Wd; int K, lda, ldb;
    __device__ __forceinline__ const char* a_base(const Unit& u) const { return (const char*)A + (size_t)u.pm * 256 * 512 * 2; }
    __device__ __forceinline__ void a_voff(const Unit&, const int (&Rp)[2], const int (&Cp)[2], unsigned (&vo)[2][2]) const {
#pragma unroll
        for (int h = 0; h < 2; ++h)
#pragma unroll
            for (int i = 0; i < 2; ++i) vo[h][i] = (unsigned)((h * 128 + Rp[i]) * 512 + Cp[i]) * 2u; }
    __device__ __forceinline__ const char* b_tile(const Unit& u, int kt) const { const int e = (kt < 4) ? u.x0 : u.x1;
        return (const char*)Wd + ((size_t)e * DM + u.pn * 256) * DEXP * 2 + (size_t)(kt & 3) * 128; } };

struct EpiP1 { static constexpr bool PERM = true;
    const float* rstd1; const float* rope; const float* qg; const float* kg; bf16_t *UB, *QB, *KB, *VB;
    __device__ __forceinline__ void operator()(const f32x4 (&acc)[2][2][4][2], const Unit& u, int wr, int wc, int fr, int fq) const {
        asm volatile("" : "+v"(fr), "+v"(fq));
        const bool meta = (u.pm == 128);
#pragma unroll
        for (int ai = 0; ai < 2; ++ai)
#pragma unroll
            for (int m = 0; m < 4; ++m) {
                const int rl = ai * 128 + wr * 64 + m * 16 + fr, grow = u.pm * 256 + rl;
                const float rs = rstd1[grow];
                const bool valid = !meta || rl < NMETA;
                const int b = grow >> 11, pos = meta ? rl : (grow & 2047) + NMETA;
                f32x4 v[2][2];
#pragma unroll
                for (int bj = 0; bj < 2; ++bj)
#pragma unroll
                    for (int n = 0; n < 2; ++n) v[bj][n] = acc[ai][bj][m][n] * rs;
                if (u.pn < 2) {
#pragma unroll
                    for (int bj = 0; bj < 2; ++bj) { u32x4 w; w.x = pg8::cvt_pk_bf16(v[bj][0][0], v[bj][0][1]); w.y = pg8::cvt_pk_bf16(v[bj][0][2], v[bj][0][3]); w.z = pg8::cvt_pk_bf16(v[bj][1][0], v[bj][1][1]); w.w = pg8::cvt_pk_bf16(v[bj][1][2], v[bj][1][3]);
                        const int col = u.pn * 256 + bj * 128 + wc * 32 + fq * 8;
                        if (!meta) *(u32x4*)(UB + ((size_t)b * LSEQ + pos) * 512 + col) = w;
                        else if (valid) { for (int bb = 0; bb < NB; ++bb) *(u32x4*)(UB + ((size_t)bb * LSEQ + pos) * 512 + col) = w; } }
                } else {
                    const bool isv = (u.pn == 4) && (wc >= 2);
                    if (!isv) {
                        float ss = 0.f;
#pragma unroll
                        for (int bj = 0; bj < 2; ++bj)
#pragma unroll
                            for (int n = 0; n < 2; ++n) ss += (v[bj][n][0] * v[bj][n][0] + v[bj][n][1] * v[bj][n][1]) + (v[bj][n][2] * v[bj][n][2] + v[bj][n][3] * v[bj][n][3]);
                        ss += __shfl_xor(ss, 16); ss += __shfl_xor(ss, 32);
                        const float rn = 1.0f / sqrtf(ss * (1.0f / HD) + EPS);
                        const float* gp = (u.pn == 4) ? kg : qg;
#pragma unroll
                        for (int bj = 0; bj < 2; ++bj)
#pragma unroll
                            for (int n = 0; n < 2; ++n) { const f32x4 gv = *(const f32x4*)(gp + 32 * bj + 8 * fq + 4 * n); v[bj][n] = v[bj][n] * rn * gv; }
#pragma unroll
                        for (int n = 0; n < 2; ++n) {
                            const f32x4 cs0 = *(const f32x4*)(rope + ((size_t)pos * 8 + 4 * n) * 2), cs1 = *(const f32x4*)(rope + ((size_t)pos * 8 + 4 * n) * 2 + 4);
                            const float c[4] = {cs0[0], cs0[2], cs1[0], cs1[2]}, s[4] = {cs0[1], cs0[3], cs1[1], cs1[3]};
#pragma unroll
                            for (int jj = 0; jj < 4; ++jj) { const float mine = v[0][n][jj], oth = __shfl_xor(mine, 16);
                                const float r = (fq == 0) ? (mine * c[jj] - oth * s[jj]) : (mine * c[jj] + oth * s[jj]);
                                v[0][n][jj] = (fq < 2) ? r : mine; }
                        }
                        if (u.pn != 4) {
#pragma unroll
                            for (int bj = 0; bj < 2; ++bj)
#pragma unroll
                                for (int n = 0; n < 2; ++n) v[bj][n] = v[bj][n] * QSCALE;
                        }
                    }
                    if (isv) {
                        const int pp = (pos & ~15) | (((pos >> 2) & 1) << 3) | (((pos >> 3) & 1) << 2) | (pos & 3); const int hh = wc & 1;
#pragma unroll
                        for (int bj = 0; bj < 2; ++bj)
#pragma unroll
                            for (int n = 0; n < 2; ++n)
#pragma unroll
                                for (int jj = 0; jj < 4; ++jj) { const int d = 32 * bj + 8 * fq + 4 * n + jj; const bf16_t hv = (bf16_t)f2bf(v[bj][n][jj]);
                                    if (!meta) VB[(((size_t)b * 2 + hh) * HD + d) * LP + pp] = hv;
                                    else if (valid) { for (int bb = 0; bb < NB; ++bb) VB[(((size_t)bb * 2 + hh) * HD + d) * LP + pp] = hv; } }
                    } else {
#pragma unroll
                    for (int bj = 0; bj < 2; ++bj) { u32x4 w; w.x = pg8::cvt_pk_bf16(v[bj][0][0], v[bj][0][1]); w.y = pg8::cvt_pk_bf16(v[bj][0][2], v[bj][0][3]); w.z = pg8::cvt_pk_bf16(v[bj][1][0], v[bj][1][1]); w.w = pg8::cvt_pk_bf16(v[bj][1][2], v[bj][1][3]);
                        const int d0 = 32 * bj + 8 * fq;
                        if (u.pn != 4) { const int head = 4 * (u.pn - 2) + wc; *(u32x4*)(QB + (size_t)grow * 512 + head * HD + d0) = w; }
                        else { const int hh = wc & 1;
                            if (!meta) *(u32x4*)(KB + (((size_t)b * 2 + hh) * LP + pos) * HD + d0) = w;
                            else if (valid) { for (int bb = 0; bb < NB; ++bb) *(u32x4*)(KB + (((size_t)bb * 2 + hh) * LP + pos) * HD + d0) = w; } } }
                    }
                }
            }
    }
};
struct EpiP3 { static constexpr bool PERM = true;
    const bf16_t* xb; bf16_t* H1; float* ss2;
    __device__ __forceinline__ void operator()(const f32x4 (&acc)[2][2][4][2], const Unit& u, int wr, int wc, int fr, int fq) const {
        asm volatile("" : "+v"(fr), "+v"(fq));
#pragma unroll
        for (int ai = 0; ai < 2; ++ai) {
            u32x4 xw[4][2];
#pragma unroll
            for (int m = 0; m < 4; ++m)
#pragma unroll
                for (int bj = 0; bj < 2; ++bj) xw[m][bj] = *(const u32x4*)(xb + (size_t)(u.pm * 256 + ai * 128 + wr * 64 + m * 16 + fr) * DM + u.pn * 256 + bj * 128 + wc * 32 + fq * 8);
#pragma unroll
            for (int m = 0; m < 4; ++m) {
                const int grow = u.pm * 256 + ai * 128 + wr * 64 + m * 16 + fr; float ss = 0.f;
#pragma unroll
                for (int bj = 0; bj < 2; ++bj) { const size_t off = (size_t)grow * DM + u.pn * 256 + bj * 128 + wc * 32 + fq * 8;
                    const u32x4 xv = xw[m][bj];
                    f32x4 h0 = acc[ai][bj][m][0], h1 = acc[ai][bj][m][1];
                    h0[0] += bflo(xv.x); h0[1] += bfhi(xv.x); h0[2] += bflo(xv.y); h0[3] += bfhi(xv.y); h1[0] += bflo(xv.z); h1[1] += bfhi(xv.z); h1[2] += bflo(xv.w); h1[3] += bfhi(xv.w);
                    ss += (h0[0] * h0[0] + h0[1] * h0[1]) + (h0[2] * h0[2] + h0[3] * h0[3]) + (h1[0] * h1[0] + h1[1] * h1[1]) + (h1[2] * h1[2] + h1[3] * h1[3]);
                    u32x4 w; w.x = pg8::cvt_pk_bf16(h0[0], h0[1]); w.y = pg8::cvt_pk_bf16(h0[2], h0[3]); w.z = pg8::cvt_pk_bf16(h1[0], h1[1]); w.w = pg8::cvt_pk_bf16(h1[2], h1[3]);
                    *(u32x4*)(H1 + off) = w; }
                ss += __shfl_xor(ss, 16); ss += __shfl_xor(ss, 32);
                if (fq == 0) ss2[(size_t)(u.pn * 4 + wc) * T + grow] = ss;
            }
        }
    }
};
struct EpiG1 { static constexpr bool PERM = true;
    bf16_t* HID; const LAS float* rstdT; const LAS float* wloT; const LAS float* whiT;
    __device__ __forceinline__ void operator()(const f32x4 (&acc)[2][2][4][2], const Unit& u, int wr, int wc, int fr, int fq) const {
        asm volatile("" : "+v"(fr), "+v"(fq));
        const LAS float* wT = (u.pn < 2) ? wloT : whiT;
#pragma unroll
        for (int ai = 0; ai < 2; ++ai)
#pragma unroll
            for (int m = 0; m < 4; ++m) {
                const int rl = ai * 128 + wr * 64 + m * 16 + fr; const float rs = rstdT[u.ui * 256 + rl], w = wT[u.ui * 256 + rl];
                float h[8];
#pragma unroll
                for (int n = 0; n < 2; ++n)
#pragma unroll
                    for (int jj = 0; jj < 4; ++jj) { const float g = acc[ai][0][m][n][jj] * rs, up = acc[ai][1][m][n][jj] * rs;
                        h[n * 4 + jj] = g / (1.0f + __expf(-g)) * up * w; }
                u32x4 o; o.x = pg8::cvt_pk_bf16(h[0], h[1]); o.y = pg8::cvt_pk_bf16(h[2], h[3]); o.z = pg8::cvt_pk_bf16(h[4], h[5]); o.w = pg8::cvt_pk_bf16(h[6], h[7]);
                *(u32x4*)(HID + ((size_t)u.pm * 256 + rl) * 512 + u.pn * 128 + wc * 32 + fq * 8) = o;
            }
    }
};
struct EpiG2 { static constexpr bool PERM = false;
    float* out; const bf16_t* H1; const LAS int* tokT; float* dump;
    __device__ __forceinline__ void operator()(const f32x4 (&acc)[2][2][4][2], const Unit& u, int wr, int wc, int fr, int fq) const {
        asm volatile("" : "+v"(fr), "+v"(fq));
        const int colb = u.pn * 256 + wc * 32 + fq * 4;
#pragma unroll
        for (int ai = 0; ai < 2; ++ai) {
            u32x2 hb[4][2][2]; int tok[4];
#pragma unroll
            for (int m = 0; m < 4; ++m) { const int rl = ai * 128 + wr * 64 + m * 16 + fr; tok[m] = tokT[u.ui * 256 + rl];
#pragma unroll
                for (int bj = 0; bj < 2; ++bj)
#pragma unroll
                    for (int n = 0; n < 2; ++n) hb[m][bj][n] = *(const u32x2*)(H1 + (size_t)tok[m] * DM + colb + bj * 128 + n * 16); }
#pragma unroll
            for (int m = 0; m < 4; ++m) { const int rl = ai * 128 + wr * 64 + m * 16 + fr;
                float* dst = (rl < u.nv) ? out + (size_t)tok[m] * DM : dump + (size_t)rl * DM;
#pragma unroll
                for (int bj = 0; bj < 2; ++bj)
#pragma unroll
                    for (int n = 0; n < 2; ++n) { const u32x2 h2 = hb[m][bj][n];
                        f32x4 o = acc[ai][bj][m][n]; o[0] += bflo(h2.x); o[1] += bfhi(h2.x); o[2] += bflo(h2.y); o[3] += bfhi(h2.y);
                        *(f32x4*)(dst + colb + bj * 128 + n * 16) = o; }
            }
        }
    }
};

__device__ __forceinline__ void p2_pool(Frame& F) {
    const int gw = F.vcu * 8 + F.wave, NGW = F.G * 8, lane = F.lane;
    const int g = lane >> 4, w = 2 << g; const float invw = 1.0f / (float)w;
    for (int task = gw; task < T / 16; task += NGW) {
        const int m0 = task * 16, b = m0 >> 11, pos0 = (m0 & 2047) + NMETA;
        const bf16_t* up = F.UB + ((size_t)b * LSEQ + pos0) * 512 + lane * 8;
        float a[8];
#pragma unroll
        for (int j = 0; j < 8; ++j) a[j] = 0.f;
        for (int i = 1; i < w; ++i) { const u32x4 q = *(const u32x4*)(up - (size_t)i * 512);
            a[0] += bflo(q.x); a[1] += bfhi(q.x); a[2] += bflo(q.y); a[3] += bfhi(q.y); a[4] += bflo(q.z); a[5] += bfhi(q.z); a[6] += bflo(q.w); a[7] += bfhi(q.w); }
#pragma unroll 4
        for (int t = 0; t < 16; ++t) {
            const u32x4 nw = *(const u32x4*)(up + (size_t)t * 512);
            a[0] += bflo(nw.x); a[1] += bfhi(nw.x); a[2] += bflo(nw.y); a[3] += bfhi(nw.y); a[4] += bflo(nw.z); a[5] += bfhi(nw.z); a[6] += bflo(nw.w); a[7] += bfhi(nw.w);
            u32x4 o;
            o.x = pk2(a[0] * invw - bflo(nw.x), a[1] * invw - bfhi(nw.x)); o.y = pk2(a[2] * invw - bflo(nw.y), a[3] * invw - bfhi(nw.y));
            o.z = pk2(a[4] * invw - bflo(nw.z), a[5] * invw - bfhi(nw.z)); o.w = pk2(a[6] * invw - bflo(nw.w), a[7] * invw - bfhi(nw.w));
            *(u32x4*)(F.YMIX + (size_t)(m0 + t) * DM + lane * 8) = o;
            const u32x4 od = *(const u32x4*)(up + (long)(t - (w - 1)) * 512);
            a[0] -= bflo(od.x); a[1] -= bfhi(od.x); a[2] -= bflo(od.y); a[3] -= bfhi(od.y); a[4] -= bflo(od.z); a[5] -= bfhi(od.z); a[6] -= bflo(od.w); a[7] -= bfhi(od.w);
        }
    }
}
typedef float f32x16 __attribute__((ext_vector_type(16)));
__device__ __forceinline__ unsigned cvtpk_s(float lo, float hi) { typedef __bf16 bf16x2_t __attribute__((ext_vector_type(2))); f32x2 v = {lo, hi}; bf16x2_t b = __builtin_convertvector(v, bf16x2_t); return __builtin_bit_cast(unsigned, b); }
constexpr int ATT_IMG = 65536, ATT_VOFF = 32768;
struct AttStage { u32x4 k[4]; u32x4 v[4]; };
__device__ __forceinline__ void att_band_load(AttStage& st, const bf16_t* Kb, const bf16_t* Vb, int kl, int tid) {
#pragma unroll
    for (int j = 0; j < 4; ++j) { const int p = tid + 512 * j, key = p >> 3, c = p & 7, slot = key >> 5; int tile = (slot == 0) ? 0 : kl + slot - 1; tile = tile < 0 ? 0 : tile;
        st.k[j] = *(const u32x4*)(Kb + ((size_t)tile * 32 + (key & 31)) * HD + c * 8); }
#pragma unroll
    for (int j = 0; j < 4; ++j) { const int p = tid + 512 * j, d = p >> 5, c = p & 31, slot = c >> 2; int tile = (slot == 0) ? 0 : kl + slot - 1; tile = tile < 0 ? 0 : tile;
        st.v[j] = *(const u32x4*)(Vb + (size_t)d * LP + tile * 32 + (c & 3) * 8); }
}
__device__ __forceinline__ void att_band_store(const AttStage& st, LAS unsigned char* img, int tid) {
#pragma unroll
    for (int j = 0; j < 4; ++j) { const int p = tid + 512 * j, key = p >> 3, c = p & 7; *(LAS u32x4*)(img + key * 128 + ((c ^ (key & 7)) << 4)) = st.k[j]; }
#pragma unroll
    for (int j = 0; j < 4; ++j) { const int p = tid + 512 * j, d = p >> 5, c = p & 31; *(LAS u32x4*)(img + ATT_VOFF + d * 512 + ((c ^ (d & 15)) << 4)) = st.v[j]; }
}
template <int MODE>
__device__ __forceinline__ void attn_tile(f32x16& o0, f32x16& o1, float& l, const bf16x8 (&qf)[4], const LAS unsigned char* img, int slot, int r, int h, float cinit, int x, int thr, bool ex) {
    f32x16 s;
#pragma unroll
    for (int i = 0; i < 16; ++i) s[i] = cinit;
    const int key = slot * 32 + r;
    const LAS unsigned char* kp = img + key * 128;
#pragma unroll
    for (int ks = 0; ks < 4; ++ks) { const bf16x8 kf = *(const LAS bf16x8*)(kp + (((2 * ks + h) ^ (key & 7)) << 4)); s = __builtin_amdgcn_mfma_f32_32x32x16_bf16(kf, qf[ks], s, 0, 0, 0); }
    float e[16];
#pragma unroll
    for (int i = 0; i < 16; ++i) {
        const int c = (i & 3) + 8 * (i >> 2);
        float v = __builtin_amdgcn_exp2f(s[i]);
        if (MODE == 1) { bool vis = (x - c) < thr; if (i < 8) vis = vis || ex; v = vis ? v : 0.f; }
        if (MODE == 2) { const bool vis = (x - c) >= thr; v = vis ? v : 0.f; }
        if (MODE == 3) { if (i >= 8) v = 0.f; }
        e[i] = v; l += v;
    }
    bf16x8 pf0, pf1;
    { u32x4 w0, w1;
      w0.x = cvtpk_s(e[0], e[1]); w0.y = cvtpk_s(e[2], e[3]); w0.z = cvtpk_s(e[4], e[5]); w0.w = cvtpk_s(e[6], e[7]);
      w1.x = cvtpk_s(e[8], e[9]); w1.y = cvtpk_s(e[10], e[11]); w1.z = cvtpk_s(e[12], e[13]); w1.w = cvtpk_s(e[14], e[15]);
      pf0 = __builtin_bit_cast(bf16x8, w0); pf1 = __builtin_bit_cast(bf16x8, w1); }
    const LAS unsigned char* vp = img + ATT_VOFF + r * 512; const int sw = r & 15;
    { const bf16x8 v00 = *(const LAS bf16x8*)(vp + (((4 * slot + h) ^ sw) << 4)), v10 = *(const LAS bf16x8*)(vp + 32 * 512 + (((4 * slot + h) ^ sw) << 4));
      o0 = __builtin_amdgcn_mfma_f32_32x32x16_bf16(v00, pf0, o0, 0, 0, 0); o1 = __builtin_amdgcn_mfma_f32_32x32x16_bf16(v10, pf0, o1, 0, 0, 0); }
    if (MODE != 3) { const bf16x8 v01 = *(const LAS bf16x8*)(vp + (((4 * slot + 2 + h) ^ sw) << 4)), v11 = *(const LAS bf16x8*)(vp + 32 * 512 + (((4 * slot + 2 + h) ^ sw) << 4));
      o0 = __builtin_amdgcn_mfma_f32_32x32x16_bf16(v01, pf1, o0, 0, 0, 0); o1 = __builtin_amdgcn_mfma_f32_32x32x16_bf16(v11, pf1, o1, 0, 0, 0); }
}
__device__ __forceinline__ void p2_attn(Frame& F) {
    const int lane = F.lane, wave = F.wave, tid = F.tid, r = lane & 31, h = lane >> 5;
    const float gq = wave_max(fabsf(F.qg[lane])), gk = wave_max(fabsf(F.kg[lane]));
    const float cb = 8.0f * LOG2E * gq * gk * 1.01f;
    const int x = r - 4 * h;
    const float NEG = -1.0e30f;
    const int NT2 = NB * NKVH * 32;
    int cur = 0;
    AttStage st;
    if (F.vcu < NT2) { const int bt = F.vcu, b = bt >> 6, kvh = (bt >> 5) & 1, kl = 2 * (bt & 31) - 4;
        att_band_load(st, F.KB + ((size_t)b * 2 + kvh) * LP * HD, F.VB + ((size_t)b * 2 + kvh) * HD * LP, kl, tid);
        att_band_store(st, F.lds, tid); }
    __syncthreads();
    for (int bt = F.vcu; bt < NT2; bt += F.G) {
        const int b = bt >> 6, kvh = (bt >> 5) & 1, a = wave >> 2, qt = 2 * (bt & 31) + a, hq = wave & 3, head = kvh * 4 + hq;
        const int btn = bt + F.G; const bool has_next = btn < NT2;
        if (has_next) { const int bn = btn >> 6, kvn = (btn >> 5) & 1, kln = 2 * (btn & 31) - 4;
            att_band_load(st, F.KB + ((size_t)bn * 2 + kvn) * LP * HD, F.VB + ((size_t)bn * 2 + kvn) * HD * LP, kln, tid); }
        const LAS unsigned char* img = F.lds + cur * ATT_IMG;
        const int m0 = b * SEQ + 32 * qt;
        const bf16_t* qp = F.QB + (size_t)(m0 + r) * 512 + head * HD + 8 * h;
        bf16x8 qf[4];
#pragma unroll
        for (int ks = 0; ks < 4; ++ks) qf[ks] = *(const bf16x8*)(qp + 16 * ks);
        f32x16 o0, o1;
#pragma unroll
        for (int i = 0; i < 16; ++i) { o0[i] = 0.f; o1[i] = 0.f; }
        float l = 0.f;
        attn_tile<3>(o0, o1, l, qf, img, 0, r, h, (qt >= 5) ? -cb : NEG, x, 0, false);
        attn_tile<1>(o0, o1, l, qf, img, 1 + a, r, h, (qt - 4 >= 0) ? -cb : NEG, x, -16, qt - 4 == 0);
        attn_tile<1>(o0, o1, l, qf, img, 2 + a, r, h, (qt - 3 >= 0) ? -cb : NEG, x, 16, qt - 3 == 0);
        attn_tile<0>(o0, o1, l, qf, img, 3 + a, r, h, (qt - 2 >= 0) ? -cb : NEG, x, 0, false);
        attn_tile<0>(o0, o1, l, qf, img, 4 + a, r, h, (qt - 1 >= 0) ? -cb : NEG, x, 0, false);
        attn_tile<2>(o0, o1, l, qf, img, 5 + a, r, h, -cb, x, -16, false);
        attn_tile<2>(o0, o1, l, qf, img, 6 + a, r, h, -cb, x, 16, false);
        l += __shfl_xor(l, 32);
        l += __builtin_amdgcn_exp2f(F.sinks[head] * LOG2E - cb);
        const float inv = 1.0f / l;
        bf16_t* op = F.YMIX + (size_t)(m0 + r) * DM + 512 + head * HD + 4 * h;
#pragma unroll
        for (int g4 = 0; g4 < 4; ++g4) {
            u32x2 w0, w1;
            w0.x = cvtpk_s(o0[4 * g4] * inv, o0[4 * g4 + 1] * inv); w0.y = cvtpk_s(o0[4 * g4 + 2] * inv, o0[4 * g4 + 3] * inv);
            w1.x = cvtpk_s(o1[4 * g4] * inv, o1[4 * g4 + 1] * inv); w1.y = cvtpk_s(o1[4 * g4 + 2] * inv, o1[4 * g4 + 3] * inv);
            *(u32x2*)(op + 8 * g4) = w0; *(u32x2*)(op + 32 + 8 * g4) = w1;
        }
        if (has_next) att_band_store(st, F.lds + (cur ^ 1) * ATT_IMG, tid);
        __syncthreads();
        cur ^= 1;
    }
}

__device__ __forceinline__ void p4_route(Frame& F, int dummy) {
    const int lane = F.lane, wave = F.wave, tid = F.tid;
    LAS float* lg = (LAS float*)(F.lds) + wave * 512;
    LAS int* hist = (LAS int*)(F.lds + 32768);
    for (int chunk = F.vcu; chunk < T / 128; chunk += F.G) {
        if (tid < 48) hist[tid] = 0;
        __syncthreads();
        const int tok0 = chunk * 128 + wave * 16;
        f32x4 a0 = {0.f, 0.f, 0.f, 0.f}, a1 = {0.f, 0.f, 0.f, 0.f};
        const bf16_t* hp = F.H1 + (size_t)(tok0 + (lane & 15)) * DM + 8 * (lane >> 4);
        const bf16_t* wp = F.Wr_t + (size_t)(lane & 15) * DM + 8 * (lane >> 4);
#pragma unroll 8
        for (int kk = 0; kk < 32; ++kk) { const bf16x8 a = *(const bf16x8*)(hp + kk * 32), b0 = *(const bf16x8*)(wp + kk * 32), b1 = *(const bf16x8*)(wp + 16 * DM + kk * 32);
            a0 = __builtin_amdgcn_mfma_f32_16x16x32_bf16(a, b0, a0, 0, 0, 0); a1 = __builtin_amdgcn_mfma_f32_16x16x32_bf16(a, b1, a1, 0, 0, 0); }
#pragma unroll
        for (int r = 0; r < 4; ++r) { lg[(4 * (lane >> 4) + r) * 32 + (lane & 15)] = a0[r]; lg[(4 * (lane >> 4) + r) * 32 + 16 + (lane & 15)] = a1[r]; }
        LDS_WAIT(); asm volatile("" ::: "memory");
        int p = 0, rank = 0; float wlo = 0.f, whi = 0.f, rs = 0.f; const int tok = tok0 + lane;
        if (lane < 16) {
            float ss = 0.f;
#pragma unroll
            for (int q = 0; q < 16; ++q) ss += F.ss2[(size_t)q * T + tok];
            rs = 1.0f / sqrtf(ss * (1.0f / DM) + EPS);
            const LAS float* l = lg + lane * 32;
            const float g0 = l[16] * rs, g1 = l[17] * rs, g2 = l[18] * rs, g3 = l[19] * rs;
            int gi = 0; float gm = g0; if (g1 > gm) { gm = g1; gi = 1; } if (g2 > gm) { gm = g2; gi = 2; } if (g3 > gm) { gm = g3; gi = 3; }
            const float gprob = 1.0f / (expf(g0 - gm) + expf(g1 - gm) + expf(g2 - gm) + expf(g3 - gm));
            const float e0 = l[gi * 4 + 0] * rs, e1 = l[gi * 4 + 1] * rs, e2 = l[gi * 4 + 2] * rs, e3 = l[gi * 4 + 3] * rs;
            int i1 = 0; float v1 = e0; if (e1 > v1) { v1 = e1; i1 = 1; } if (e2 > v1) { v1 = e2; i1 = 2; } if (e3 > v1) { v1 = e3; i1 = 3; }
            int i2 = -1; float v2 = -3.0e38f;
            if (i1 != 0 && e0 > v2) { v2 = e0; i2 = 0; } if (i1 != 1 && e1 > v2) { v2 = e1; i2 = 1; } if (i1 != 2 && e2 > v2) { v2 = e2; i2 = 2; } if (i1 != 3 && e3 > v2) { v2 = e3; i2 = 3; }
            const float p1 = 1.0f / (1.0f + expf(v2 - v1)), p2 = 1.0f - p1;
            const float w1 = p1 * gprob, w2 = p2 * gprob;
            const int lo = i1 < i2 ? i1 : i2, hi = i1 < i2 ? i2 : i1;
            wlo = i1 < i2 ? w1 : w2; whi = i1 < i2 ? w2 : w1;
            const int pidx = (lo == 0) ? (hi - 1) : (lo == 1 ? hi + 1 : 5);
            p = gi * 6 + pidx;
            rank = __hip_atomic_fetch_add(&hist[p], 1, __ATOMIC_RELAXED, __HIP_MEMORY_SCOPE_WORKGROUP);
        }
        __syncthreads();
        if (tid < NPAIR) hist[24 + tid] = (int)atomicAdd(F.ctl + CW_CNT + dummy * 32 + tid, (unsigned)hist[tid]);
        __syncthreads();
        if (lane < 16) { const int slot = hist[24 + p] + rank; int* lp = dummy ? (int*)F.HID : F.list; float* r2 = dummy ? (float*)F.HID + 2 * MiB : F.rstd2; float* wl = dummy ? (float*)F.HID + 3 * MiB : F.wlo; float* wh = dummy ? (float*)F.HID + 4 * MiB : F.whi;
            lp[(size_t)p * T + slot] = tok; r2[tok] = rs; wl[tok] = wlo; wh[tok] = whi; }
        __syncthreads();
    }
}
__device__ __forceinline__ void moe_tables(Frame& F) {
    LAS int* tokT = (LAS int*)(F.lds + TAB_TOK); LAS float* rstdT = (LAS float*)(F.lds + TAB_RSTD); LAS float* wloT = (LAS float*)(F.lds + TAB_WLO); LAS float* whiT = (LAS float*)(F.lds + TAB_WHI);
    LAS int* hdr = (LAS int*)(F.lds + TAB_HDR); LAS int* pre = hdr + 64;
    const int tid = F.tid;
    if (tid < NPAIR) pre[32 + tid] = (int)__hip_atomic_load(F.ctl + CW_CNT + tid, __ATOMIC_RELAXED, __HIP_MEMORY_SCOPE_AGENT);
    __syncthreads();
    if (tid == 0) { int s = 0; for (int p = 0; p < NPAIR; ++p) { pre[p] = s; s += (pre[32 + p] + 255) >> 8; } pre[NPAIR] = s; }
    __syncthreads();
    const int NT = pre[NPAIR];
    int nu = 0;
    for (int ui = 0; ui < MAXU; ++ui) {
        const int L = ui * F.G + F.vcu; if (L >= 4 * NT) break;
        const int rt = L >> 2, j = L & 3; int p = 0;
        for (int q = 0; q < NPAIR; ++q) if (pre[q] <= rt && rt < pre[q + 1]) p = q;
        const int t = rt - pre[p], cntp = pre[32 + p]; const int nv = (cntp - 256 * t) < 256 ? (cntp - 256 * t) : 256;
        const int g = p / 6, pi = p % 6; const int lo = (pi < 3) ? 0 : (pi < 5 ? 1 : 2); const int hi = (pi < 3) ? pi + 1 : (pi < 5 ? pi - 1 : 3);
        if (tid == 0) { hdr[ui * 8 + 0] = rt; hdr[ui * 8 + 1] = j; hdr[ui * 8 + 2] = g * 4 + lo; hdr[ui * 8 + 3] = g * 4 + hi; hdr[ui * 8 + 4] = nv; }
        if (tid < 256) { const int r = tid < nv ? tid : 0; const int tok = F.list[(size_t)p * T + 256 * t + r];
            tokT[ui * 256 + tid] = tok; rstdT[ui * 256 + tid] = F.rstd2[tok]; wloT[ui * 256 + tid] = tid < nv ? F.wlo[tok] : 0.f; whiT[ui * 256 + tid] = tid < nv ? F.whi[tok] : 0.f; }
        ++nu;
    }
    if (tid == 0) hdr[MAXU * 8] = nu;
    __syncthreads();
}

struct Args { const float* in[16]; float* out; unsigned char* ws; int ph_lo, ph_hi; int reps[10]; };
constexpr int N_LAUNCHES = MK_N_LAUNCHES;
constexpr int PER_PHASE = 7;

__global__ void __launch_bounds__(512, 2) hymba_fwd(Args args) {
    extern __shared__ __attribute__((aligned(16))) unsigned char lds[];
    Frame F;
    F.lds = (LAS unsigned char*)lds;
    F.MISC = (volatile LAS unsigned*)(F.lds + MISC_OFF);
    F.tid = threadIdx.x; F.lane = F.tid & 63; F.wave = __builtin_amdgcn_readfirstlane(F.tid >> 6);
    F.G = gridDim.x; { const int bx = blockIdx.x; F.vcu = (F.G % 8 == 0) ? (bx % 8) * (F.G / 8) + bx / 8 : bx; }
    unsigned char* ws = args.ws;
    F.ctl = (unsigned*)(ws + WS_CTL);
    F.x = args.in[0]; F.meta = args.in[1]; F.g1 = args.in[2]; F.win = args.in[3]; F.wpool = args.in[4]; F.pscale = args.in[5]; F.qg = args.in[6]; F.kg = args.in[7];
    F.sinks = args.in[8]; F.wout = args.in[9]; F.g2 = args.in[10]; F.wgr = args.in[11]; F.wer = args.in[12]; F.wgate = args.in[13]; F.wup = args.in[14]; F.wdown = args.in[15];
    F.out = args.out;
    F.Win_t = (bf16_t*)(ws + WS_WIN); F.Wout_t = (bf16_t*)(ws + WS_WOUT); F.Wgu_t = (bf16_t*)(ws + WS_WGU); F.Wd_t = (bf16_t*)(ws + WS_WD); F.Wr_t = (bf16_t*)(ws + WS_WR);
    F.XB = (bf16_t*)(ws + WS_XB); F.UB = (bf16_t*)(ws + WS_U); F.QB = (bf16_t*)(ws + WS_Q); F.KB = (bf16_t*)(ws + WS_K); F.VB = (bf16_t*)(ws + WS_V);
    F.YMIX = (bf16_t*)(ws + WS_YMIX); F.H1 = (bf16_t*)(ws + WS_H1); F.HID = (bf16_t*)(ws + WS_HID);
    F.rope = (float*)(ws + WS_ROPE); F.rstd1 = (float*)(ws + WS_RSTD1); F.rstd2 = (float*)(ws + WS_RSTD2); F.wlo = (float*)(ws + WS_WLO); F.whi = (float*)(ws + WS_WHI); F.ss2 = (float*)(ws + WS_SS2);
    F.list = (int*)(ws + WS_LIST);
    for (int u = F.tid; u < (LDS_BYTES - TAB_HDR) / 4; u += 512) ((LAS unsigned*)(F.lds + TAB_HDR))[u] = 0u;
    __syncthreads();
    XcdBarrier bar; bar.bar = (unsigned*)(F.ctl + CW_BAR); bar.x = 0; bar.st = nullptr;
    if (N_LAUNCHES == 1) bar = xcd_barrier_post((unsigned*)(F.ctl + CW_BAR), F.MISC + 8);
    const int lo = args.ph_lo, hi = args.ph_hi;
#ifndef PHASE_MASK
#define PHASE_MASK 0x7f
#endif
#define IN(k) (((PHASE_MASK >> (k)) & 1) && lo <= (k) && (k) < hi)
#define BOTH(k) (IN(k) && IN((k) + 1))
#define GRID_BAR() do { if (N_LAUNCHES == 1) { for (int rb_ = 0; rb_ < NBAR_; ++rb_) xcd_barrier(bar); } } while (0)
#ifndef REPEAT_MASK
#define REPEAT_MASK 0
#endif
#if REPEAT_MASK
#define REP(k) for (int rep_ = 0; rep_ < args.reps[k]; ++rep_)
#define REPI rep_
#define NBAR_ args.reps[8]
#else
#define REP(k)
#define REPI 0
#define NBAR_ 1
#endif

    if (IN(0)) { REP(0) { p0_prologue(F); if (N_LAUNCHES != 1) late_weights(F, F.vcu * 8 + F.wave, F.G * 8); } if (BOTH(0)) GRID_BAR(); }

    if (IN(1)) {
        ProbLinear P{F.XB, F.Win_t, DM, DM, DM}; SchedP1 S{F.G, F.vcu};
        EpiP1 E{F.rstd1, F.rope, F.qg, F.kg, F.UB, F.QB, F.KB, F.VB};
        REP(1) { pg8::gemm_phase(F.lds, P, S, E); }
        if (N_LAUNCHES == 1) { const int nfull = 643 % F.G;
            if (F.vcu >= nfull) late_weights(F, (F.vcu - nfull) * 8 + F.wave, (F.G - nfull) * 8); }
        if (BOTH(1)) GRID_BAR();
    }
    if (IN(2)) { REP(2) { p2_pool(F); } REP(7) { p2_attn(F); } if (BOTH(2)) GRID_BAR(); }
    if (IN(3)) {
        ProbLinear P{F.YMIX, F.Wout_t, DM, DM, DM}; SchedP3 S{F.G, F.vcu};
        EpiP3 E{F.XB, F.H1, F.ss2};
        REP(3) { pg8::gemm_phase(F.lds, P, S, E); }
        if (BOTH(3)) GRID_BAR();
    }
    if (IN(4)) { REP(4) { p4_route(F, REPI); } if (BOTH(4)) GRID_BAR(); }
    if (IN(5)) {
        moe_tables(F);
        ProbG1 P{F.H1, F.Wgu_t, (const LAS int*)(F.lds + TAB_TOK), DM, DM, DM}; SchedMoe S{(const LAS int*)(F.lds + TAB_HDR)};
        EpiG1 E{F.HID, (const LAS float*)(F.lds + TAB_RSTD), (const LAS float*)(F.lds + TAB_WLO), (const LAS float*)(F.lds + TAB_WHI)};
        REP(5) { pg8::gemm_phase(F.lds, P, S, E); }
        if (BOTH(5)) GRID_BAR();
    }
    if (IN(6)) {
        if (!IN(5)) moe_tables(F);
        ProbG2 P{F.HID, F.Wd_t, 512, 512, DEXP}; SchedMoe S{(const LAS int*)(F.lds + TAB_HDR)};
        EpiG2 E{F.out, F.H1, (const LAS int*)(F.lds + TAB_TOK), (float*)(ws + WS_DUMP)};
        REP(6) { pg8::gemm_phase(F.lds, P, S, E); }
    }
#undef IN
#undef BOTH
}

extern "C" void kernel_launch(void* const* d_in, const int* in_sizes, int n_in, void* d_out, int out_size, void* d_ws, size_t ws_size, hipStream_t stream) {
    static int grid = 0;
    if (grid == 0) {
        if (n_in != 16 || in_sizes[0] != T * DM || out_size != T * DM || ws_size < WS_END) { fprintf(stderr, "kernel_launch: unexpected shapes (n_in %d, in0 %d, out %d, ws %zu)\n", n_in, n_in > 0 ? in_sizes[0] : -1, out_size, ws_size); grid = -1; return; }
        int dev = 0, cus = 0, per_cu = 0;
        if (hipGetDevice(&dev) != hipSuccess || hipDeviceGetAttribute(&cus, hipDeviceAttributeMultiprocessorCount, dev) != hipSuccess) { grid = -1; return; }
        if (hipFuncSetAttribute((const void*)hymba_fwd, hipFuncAttributeMaxDynamicSharedMemorySize, LDS_BYTES) != hipSuccess) { fprintf(stderr, "kernel_launch: hipFuncSetAttribute failed\n"); grid = -1; return; }
        if (hipOccupancyMaxActiveBlocksPerMultiprocessor(&per_cu, (const void*)hymba_fwd, 512, LDS_BYTES) != hipSuccess || per_cu < 1)
            fprintf(stderr, "kernel_launch: occupancy query reports %d workgroups per CU\n", per_cu);
        (void)hipGetLastError();
        grid = cus;
    }
    if (grid < 0) return;
    if (hipMemsetAsync((char*)d_ws + WS_CTL, 0, CTL_ZERO_BYTES, stream) != hipSuccess) { fprintf(stderr, "kernel_launch: memset failed\n"); return; }
    Args a{};
    for (int i = 0; i < 16; ++i) a.in[i] = (const float*)d_in[i];
    a.out = (float*)d_out; a.ws = (unsigned char*)d_ws;
    for (int i = 0; i < 10; ++i) a.reps[i] = ((REPEAT_MASK >> i) & 1) ? 2 : 1;
    for (int li = 0; li < N_LAUNCHES; ++li) {
        a.ph_lo = (N_LAUNCHES == PER_PHASE) ? li : 0; a.ph_hi = (N_LAUNCHES == PER_PHASE) ? li + 1 : PER_PHASE;
        hipLaunchKernelGGL(hymba_fwd, dim3(grid), dim3(512), LDS_BYTES, stream, a);
        const hipError_t le = hipPeekAtLastError();
        if (le != hipSuccess) { fprintf(stderr, "kernel_launch: launch %d failed: %s\n", li, hipGetErrorName(le)); break; }
    }
}
```
